# Optimizing an MI355X kernel written in HIP

```python
import math
import jax, jax.numpy as jnp
from jax import lax
import numpy as np

D_MODEL = 1024
BATCH = 8
SEQ = 2048
DEPTH = 2
DEC_BATCH = 128
DEC_SEQ = 1
PAST_LEN = 16384
PAGE_SIZE = 128

N_MEM = 256
E_SSM = D_MODEL // 2
SSM_GROUP = 16
N_SSM_GROUPS = E_SSM // SSM_GROUP
SSM_STATE = 64
DT_MIN = 1e-3
DT_MAX = 1e-1
E_CONV = D_MODEL // 2
CONV_WIDTH = 31
E_XATT = D_MODEL // 2
N_XHEADS = 4
XHEAD_DIM = E_XATT // N_XHEADS
EPS = 1e-6

IN_SIZES = (E_SSM, E_SSM, 2 * E_CONV, E_CONV, E_XATT, E_XATT, D_MODEL, D_MODEL, D_MODEL)
IN_TOTAL = int(sum(IN_SIZES))
IN_SPLITS = [int(v) for v in np.cumsum(IN_SIZES)[:-1]]

kernel_name = "s5_conformer_memxattn_gated_hybrid_step"


def rmsnorm(x, g):
    xf = x.astype(jnp.float32)
    y = xf * lax.rsqrt(jnp.mean(xf * xf, axis=-1, keepdims=True) + EPS) * g.astype(jnp.float32)
    return y.astype(x.dtype)


def layernorm(x, g, b):
    xf = x.astype(jnp.float32)
    mu = jnp.mean(xf, axis=-1, keepdims=True)
    var = jnp.mean(jnp.square(xf - mu), axis=-1, keepdims=True)
    y = (xf - mu) * lax.rsqrt(var + EPS) * g.astype(jnp.float32) + b.astype(jnp.float32)
    return y.astype(x.dtype)


def _to_c(re, im):
    return lax.complex(re.astype(jnp.float32), im.astype(jnp.float32))


def _lin_rec(e1, e2):
    a1, b1 = e1
    a2, b2 = e2
    return a1 * a2, a2 * b1 + b2


def s5_branch(u, s0, a_re, a_im, log_dt, b_re, b_im, c_re, c_im, d):
    bsz, L, _ = u.shape
    uf = u.astype(jnp.float32).reshape(bsz, L, N_SSM_GROUPS, SSM_GROUP)
    lam = _to_c(a_re, a_im)
    dt = jnp.exp(log_dt.astype(jnp.float32))[:, None]
    lam_bar = jnp.exp(lam * dt)
    b_bar = ((lam_bar - 1.0) / lam)[..., None] * _to_c(b_re, b_im)
    bu = jnp.einsum('blgh,gph->blgp', uf.astype(jnp.complex64), b_bar)
    a = jnp.broadcast_to(lam_bar, bu.shape)
    a_cum, xs = lax.associative_scan(_lin_rec, (a, bu), axis=1)
    xs = xs + a_cum * s0[:, None]
    y = jnp.einsum('blgp,ghp->blgh', xs, _to_c(c_re, c_im)).real
    y = y + d.astype(jnp.float32).reshape(N_SSM_GROUPS, SSM_GROUP) * uf
    return y.reshape(bsz, L, E_SSM), xs[:, -1]


def causal_depthwise_conv(v, buf, w, b):
    full = jnp.concatenate([buf.astype(v.dtype), v], axis=1)
    out = lax.conv_general_dilated(full, w.astype(v.dtype)[:, None, :], window_strides=(1,), padding='VALID',
                                   dimension_numbers=('NWC', 'WIO', 'NWC'), feature_group_count=E_CONV)
    return out + b.astype(v.dtype), full[:, -(CONV_WIDTH - 1):]


def mem_kv(mem, g, w_k, w_v):
    hm = rmsnorm(mem, g)
    bsz = mem.shape[0]
    k = (hm @ w_k).reshape(bsz, N_MEM, N_XHEADS, XHEAD_DIM)
    v = (hm @ w_v).reshape(bsz, N_MEM, N_XHEADS, XHEAD_DIM)
    return k, v


def mixer_layer(x, s0_re, s0_im, conv_buf, mk, mv, p):
    bsz, L, _ = x.shape
    h = rmsnorm(x, p['norm_g'])
    u_a, z_a, u_b, z_b, q, z_x, g_a, g_b, g_x = jnp.split(h @ p['w_in'], IN_SPLITS, axis=-1)
    s0 = _to_c(s0_re, s0_im)
    y_a, s_new = s5_branch(u_a, s0, p['a_re'], p['a_im'], p['log_dt'], p['b_re'], p['b_im'],
                           p['c_re'], p['c_im'], p['d'])
    y_a = jax.nn.gelu(y_a).astype(x.dtype)
    y_a = y_a * jax.nn.sigmoid(y_a @ p['w_glu'] + p['b_glu'])
    o_a = (y_a * jax.nn.silu(z_a)) @ p['w_br_ssm']
    v_b = u_b[..., :E_CONV] * jax.nn.sigmoid(u_b[..., E_CONV:])
    c_b, buf_new = causal_depthwise_conv(v_b, conv_buf, p['conv_w'], p['conv_b'])
    c_b = jax.nn.silu(layernorm(c_b, p['ln_g'], p['ln_b']))
    o_b = (c_b * jax.nn.silu(z_b)) @ p['w_br_conv']
    qh = q.reshape(bsz, L, N_XHEADS, XHEAD_DIM).astype(jnp.float32)
    s = jnp.einsum('blhd,bmhd->bhlm', qh, mk.astype(jnp.float32)) * (1.0 / math.sqrt(XHEAD_DIM))
    prob = jax.nn.softmax(s, axis=-1).astype(mv.dtype)
    o_x = jnp.einsum('bhlm,bmhd->blhd', prob, mv).reshape(bsz, L, E_XATT).astype(x.dtype)
    o_x = (o_x * jax.nn.silu(z_x)) @ p['w_br_xatt']
    m = jax.nn.sigmoid(g_a) * o_a + jax.nn.sigmoid(g_b) * o_b + jax.nn.sigmoid(g_x) * o_x
    x = x + (m @ p['w_out']).astype(x.dtype)
    return x, jnp.real(s_new), jnp.imag(s_new), buf_new


def setup_inputs(seed: int = 0) -> dict:
    key = jax.random.key(seed)
    ks = jax.random.split(key, 40)
    f32 = jnp.float32
    nrm = lambda k, shape, scale: (jax.random.normal(k, shape, f32) * scale)
    G, P, H = N_SSM_GROUPS, SSM_STATE, SSM_GROUP
    inp = {}
    inp['x_prompt'] = nrm(ks[0], (BATCH, SEQ, D_MODEL), 1.0)
    inp['x_sample'] = nrm(ks[1], (DEC_BATCH, DEC_SEQ, D_MODEL), 1.0)
    inp['mem_prompt'] = nrm(ks[2], (BATCH, N_MEM, D_MODEL), 1.0)
    inp['state_ssm_re'] = nrm(ks[3], (DEPTH, DEC_BATCH, G, P), 0.1)
    inp['state_ssm_im'] = nrm(ks[4], (DEPTH, DEC_BATCH, G, P), 0.1)
    inp['state_conv'] = nrm(ks[5], (DEPTH, DEC_BATCH, CONV_WIDTH - 1, E_CONV), 1.0)
    inp['cache_mem_k'] = nrm(ks[6], (DEPTH, DEC_BATCH, N_MEM, N_XHEADS, XHEAD_DIM), 1.0)
    inp['cache_mem_v'] = nrm(ks[7], (DEPTH, DEC_BATCH, N_MEM, N_XHEADS, XHEAD_DIM), 1.0)
    inp['norm_g'] = 1.0 + nrm(ks[8], (DEPTH, D_MODEL), 0.02)
    inp['w_in'] = nrm(ks[9], (DEPTH, D_MODEL, IN_TOTAL), D_MODEL ** -0.5)
    inp['ssm_a_re'] = -0.5 + nrm(ks[10], (DEPTH, G, P), 0.01)
    inp['ssm_a_im'] = math.pi * jnp.broadcast_to(jnp.arange(P, dtype=f32), (DEPTH, G, P)) + nrm(ks[11], (DEPTH, G, P), 0.01)
    inp['ssm_log_dt'] = jax.random.uniform(ks[12], (DEPTH, G), f32, math.log(DT_MIN), math.log(DT_MAX))
    inp['ssm_b_re'] = nrm(ks[13], (DEPTH, G, P, H), (2 * H) ** -0.5)
    inp['ssm_b_im'] = nrm(ks[14], (DEPTH, G, P, H), (2 * H) ** -0.5)
    inp['ssm_c_re'] = nrm(ks[15], (DEPTH, G, H, P), (2 * P) ** -0.5 * 4.0)
    inp['ssm_c_im'] = nrm(ks[16], (DEPTH, G, H, P), (2 * P) ** -0.5 * 4.0)
    inp['ssm_d'] = nrm(ks[17], (DEPTH, E_SSM), 1.0)
    inp['w_glu'] = nrm(ks[18], (DEPTH, E_SSM, E_SSM), E_SSM ** -0.5)
    inp['b_glu'] = nrm(ks[19], (DEPTH, E_SSM), 0.01)
    inp['w_br_ssm'] = nrm(ks[20], (DEPTH, E_SSM, D_MODEL), E_SSM ** -0.5)
    inp['conv_w'] = nrm(ks[21], (DEPTH, CONV_WIDTH, E_CONV), CONV_WIDTH ** -0.5)
    inp['conv_b'] = nrm(ks[22], (DEPTH, E_CONV), 0.01)
    inp['conv_ln_g'] = 1.0 + nrm(ks[23], (DEPTH, E_CONV), 0.02)
    inp['conv_ln_b'] = nrm(ks[24], (DEPTH, E_CONV), 0.01)
    inp['w_br_conv'] = nrm(ks[25], (DEPTH, E_CONV, D_MODEL), E_CONV ** -0.5)
    inp['mem_norm_g'] = 1.0 + nrm(ks[26], (DEPTH, D_MODEL), 0.02)
    inp['w_k'] = nrm(ks[27], (DEPTH, D_MODEL, E_XATT), D_MODEL ** -0.5)
    inp['w_v'] = nrm(ks[28], (DEPTH, D_MODEL, E_XATT), D_MODEL ** -0.5)
    inp['w_br_xatt'] = nrm(ks[29], (DEPTH, E_XATT, D_MODEL), E_XATT ** -0.5)
    inp['w_out'] = nrm(ks[30], (DEPTH, D_MODEL, D_MODEL), D_MODEL ** -0.5)
    inp['final_norm_g'] = 1.0 + nrm(ks[31], (D_MODEL,), 0.02)
    return inp


def reference(x_prompt, x_sample, mem_prompt, state_ssm_re, state_ssm_im, state_conv, cache_mem_k, cache_mem_v,
              norm_g, w_in, ssm_a_re, ssm_a_im, ssm_log_dt, ssm_b_re, ssm_b_im, ssm_c_re, ssm_c_im, ssm_d,
              w_glu, b_glu, w_br_ssm, conv_w, conv_b, conv_ln_g, conv_ln_b, w_br_conv,
              mem_norm_g, w_k, w_v, w_br_xatt, w_out, final_norm_g):
    bp = x_prompt.shape[0]
    xp, xs = x_prompt, x_sample
    p_re, p_im, p_conv, p_k, p_v = [], [], [], [], []
    s_re, s_im, s_conv = [], [], []
    for l in range(DEPTH):
        prm = {'norm_g': norm_g[l], 'w_in': w_in[l], 'a_re': ssm_a_re[l], 'a_im': ssm_a_im[l],
               'log_dt': ssm_log_dt[l], 'b_re': ssm_b_re[l], 'b_im': ssm_b_im[l], 'c_re': ssm_c_re[l],
               'c_im': ssm_c_im[l], 'd': ssm_d[l], 'w_glu': w_glu[l], 'b_glu': b_glu[l],
               'w_br_ssm': w_br_ssm[l], 'conv_w': conv_w[l], 'conv_b': conv_b[l], 'ln_g': conv_ln_g[l],
               'ln_b': conv_ln_b[l], 'w_br_conv': w_br_conv[l], 'w_br_xatt': w_br_xatt[l], 'w_out': w_out[l]}
        mk, mv = mem_kv(mem_prompt, mem_norm_g[l], w_k[l], w_v[l])
        z_state = jnp.zeros((bp, N_SSM_GROUPS, SSM_STATE), jnp.float32)
        z_buf = jnp.zeros((bp, CONV_WIDTH - 1, E_CONV), xp.dtype)
        xp, r, i, b = mixer_layer(xp, z_state, z_state, z_buf, mk, mv, prm)
        p_re.append(r); p_im.append(i); p_conv.append(b); p_k.append(mk); p_v.append(mv)
        xs, r, i, b = mixer_layer(xs, state_ssm_re[l], state_ssm_im[l], state_conv[l],
                                  cache_mem_k[l], cache_mem_v[l], prm)
        s_re.append(r); s_im.append(i); s_conv.append(b)
    y_prompt = rmsnorm(xp, final_norm_g)
    y_sample = rmsnorm(xs, final_norm_g)
    return (y_prompt, y_sample, jnp.stack(p_re), jnp.stack(p_im), jnp.stack(p_conv), jnp.stack(p_k), jnp.stack(p_v),
            jnp.stack(s_re), jnp.stack(s_im), jnp.stack(s_conv))
```

```cpp
#include <hip/hip_runtime.h>
#include <hip/hip_cooperative_groups.h>
#include <cstdio>
namespace cg = cooperative_groups;

typedef unsigned short bf16_t;
typedef short bf16x8 __attribute__((ext_vector_type(8)));
typedef float f32x4 __attribute__((ext_vector_type(4)));
typedef float f32x2 __attribute__((ext_vector_type(2)));
typedef unsigned u32x2 __attribute__((ext_vector_type(2)));
typedef unsigned u32x4 __attribute__((ext_vector_type(4)));

constexpr int DM = 1024, TP = 16384, TS = 128, TT = TP + TS, MP = 16640, SEQ = 2048, NB = 8;
constexpr int ZW = 6656;
constexpr int C_UA = 0, C_ZA = 512, C_UB = 1024, C_UG = 1536, C_ZB = 2048, C_Q = 2560, C_ZX = 3072, C_GA = 3584, C_GB = 4608, C_GX = 5632;
constexpr float EPS = 1e-6f;
constexpr int NTHREADS = 512;
constexpr int LDS_BYTES = 147456;
constexpr int LDS_ST_OFF = LDS_BYTES - 16;

enum { I_XP = 0, I_XS, I_MEM, I_SRE, I_SIM, I_SCONV, I_CK, I_CV, I_NORMG, I_WIN, I_ARE, I_AIM, I_LOGDT, I_BRE, I_BIM, I_CRE, I_CIM, I_D,
       I_WGLU, I_BGLU, I_WBRS, I_CONVW, I_CONVB, I_LNG, I_LNB, I_WBRC, I_MEMG, I_WK, I_WV, I_WBRX, I_WOUT, I_FING };

constexpr size_t O_YP = 0;
constexpr size_t O_YS = O_YP + (size_t)TP * DM;
constexpr size_t O_PRE = O_YS + (size_t)TS * DM;
constexpr size_t O_PIM = O_PRE + 2 * 8 * 32 * 64;
constexpr size_t O_PCONV = O_PIM + 2 * 8 * 32 * 64;
constexpr size_t O_PK = O_PCONV + 2 * 8 * 30 * 512;
constexpr size_t O_PV = O_PK + (size_t)2 * 8 * 256 * 512;
constexpr size_t O_SRE = O_PV + (size_t)2 * 8 * 256 * 512;
constexpr size_t O_SIM = O_SRE + (size_t)2 * 128 * 32 * 64;
constexpr size_t O_SCONV = O_SIM + (size_t)2 * 128 * 32 * 64;

constexpr size_t W_Z = 0;
constexpr size_t W_H = W_Z + (size_t)MP * ZW * 2;
constexpr size_t W_XN = W_H + (size_t)MP * DM * 2;
constexpr size_t W_YA = W_XN + (size_t)MP * DM * 4;
constexpr size_t W_ABR = W_YA + (size_t)MP * 512 * 2;
constexpr size_t W_WT = W_ABR + (size_t)MP * 1536 * 2;
constexpr size_t WT_IN = 0, WT_GLU = WT_IN + (size_t)ZW * 1024, WT_BR = WT_GLU + 512 * 512,
                 WT_K = WT_BR + 1024 * 1536, WT_V = WT_K + 512 * 1024, WT_OUT = WT_V + 512 * 1024, WT_LAYER = WT_OUT + 1024 * 1024;
constexpr size_t W_HM = W_WT + 2 * WT_LAYER * 2;
constexpr size_t W_KB = W_HM + (size_t)2 * 2048 * 1024 * 2;
constexpr size_t W_VT = W_KB + (size_t)2 * 2048 * 512 * 2;
constexpr size_t W_BAR = W_VT + (size_t)2 * 2048 * 512 * 2;
constexpr size_t W_CNT = W_BAR + 14336;
constexpr size_t W_END = W_BAR + 16384;

__device__ __forceinline__ size_t zoff(size_t row, int col) { return ((size_t)(col >> 8) * MP + row) * 256 + (size_t)(col & 255); }
struct Params {
    const float* in[32];
    float* out;
    unsigned char* ws;
};

extern __shared__ __attribute__((aligned(16))) unsigned char smem[];

__device__ __forceinline__ unsigned cvt_pk_bf16(float lo, float hi) { unsigned r; asm("v_cvt_pk_bf16_f32 %0, %1, %2" : "=v"(r) : "v"(lo), "v"(hi)); return r; }
__device__ __forceinline__ bf16_t f2bf(float f) { return (bf16_t)(cvt_pk_bf16(f, 0.f) & 0xffffu); }
__device__ __forceinline__ bf16_t f2bf_sw(float f) { unsigned u = __float_as_uint(f); u += 0x7fffu + ((u >> 16) & 1u); return (bf16_t)(u >> 16); }
__device__ __forceinline__ float bf2f(bf16_t h) { return __uint_as_float((unsigned)h << 16); }
__device__ __forceinline__ float bflo(unsigned w) { return __uint_as_float(w << 16); }
__device__ __forceinline__ float bfhi(unsigned w) { return __uint_as_float(w & 0xffff0000u); }
__device__ __forceinline__ float sigmoidf_(float x) { return __builtin_amdgcn_rcpf(1.0f + __expf(-x)); }
__device__ __forceinline__ float siluf_(float x) { return x * sigmoidf_(x); }
__device__ __forceinline__ float gelu_tanh(float x) {
    const float u = 0.7978845608028654f * (x + 0.044715f * x * x * x);
    return x * sigmoidf_(2.0f * u);
}
typedef __attribute__((address_space(4))) const unsigned char* karg_t;
__device__ __forceinline__ karg_t kargs() { karg_t k = (karg_t)__builtin_amdgcn_kernarg_segment_ptr(); asm volatile("" : "+s"(k)); return k; }
__device__ __forceinline__ const float* IN(int i) { return *(const float* __attribute__((address_space(4))) const*)(kargs() + 8 * i); }
__device__ __forceinline__ float* OUTP() { return *(float* __attribute__((address_space(4))) const*)(kargs() + 256); }
struct Params;
__device__ __forceinline__ unsigned char* WS(const Params&) { return *(unsigned char* __attribute__((address_space(4))) const*)(kargs() + 264); }
__device__ __forceinline__ int opaque_tid() { int t = threadIdx.x; asm volatile("" : "+v"(t)); return t; }
__device__ __forceinline__ float wave_sum(float v) {
#pragma unroll
    for (int o = 32; o > 0; o >>= 1) v += __shfl_xor(v, o);
    return v;
}
__device__ __forceinline__ float wave_max(float v) {
#pragma unroll
    for (int o = 32; o > 0; o >>= 1) v = fmaxf(v, __shfl_xor(v, o));
    return v;
}

#define LAS __attribute__((address_space(3)))
#define XB_TMO      128
#define XB_XCNT(j)  (256  + 64 * (j))
#define XB_XSUB(j)  (1280 + 64 * (j))
#define XB_XGEN(j)  (2304 + 64 * (j))
#define XB_TOP      3328
#define XB_TOPGEN   3392
#define XCD_BAR_WORDS 3456
#define XB_SPIN_CAP (1u << 18)
__device__ __forceinline__ unsigned xb_ld(unsigned* p)              { return __hip_atomic_load(p, __ATOMIC_RELAXED, __HIP_MEMORY_SCOPE_AGENT); }
__device__ __forceinline__ unsigned xb_add(unsigned* p, unsigned v) { return __hip_atomic_fetch_add(p, v, __ATOMIC_RELAXED, __HIP_MEMORY_SCOPE_AGENT); }
__device__ __forceinline__ unsigned xb_xcc_id() { return (unsigned)__builtin_amdgcn_s_getreg((3 << 11) | 20) & 0xFu; }
#define XB_SPIN(cond, bar) do { unsigned _sp = 0; while (cond) { __builtin_amdgcn_s_sleep(1); \
    if ((++_sp & 255u) == 0u) { if (xb_ld(&(bar)[XB_TMO])) break; if (_sp > XB_SPIN_CAP) { atomicAdd(&(bar)[XB_TMO], 1u); break; } } } } while (0)
struct XcdBarrier { unsigned* bar; unsigned x; volatile LAS unsigned* st; };
__device__ __forceinline__ XcdBarrier xcd_barrier_post(unsigned* bar, volatile LAS unsigned* st) {
    XcdBarrier b; b.bar = bar; b.x = xb_xcc_id(); b.st = st;
    if (threadIdx.x == 0) (void)xb_add(&bar[XB_XCNT(b.x)], 1u);
    return b;
}
__device__ __forceinline__ void xcd_barrier_complete(unsigned* bar, unsigned x, unsigned& nloc, unsigned& nx) {
    const unsigned G = gridDim.x * gridDim.y * gridDim.z;
    unsigned sum, cnt, mine, sp = 0u;
    for (;;) {
        sum = 0u; cnt = 0u; mine = 0u;
#pragma unroll
        for (unsigned j = 0; j < 16; ++j) { const unsigned c = xb_ld(&bar[XB_XCNT(j)]); sum += c; cnt += (c > 0u) ? 1u : 0u; mine = (j == x) ? c : mine; }
        if (sum == G) break;
        __builtin_amdgcn_s_sleep(1);
        if ((++sp & 255u) == 0u) { if (xb_ld(&bar[XB_TMO])) break; if (sp > XB_SPIN_CAP) { atomicAdd(&bar[XB_TMO], 1u); break; } }
    }
    nloc = mine > 0u ? mine : 1u; nx = cnt > 0u ? cnt : 1u;
}
__device__ __forceinline__ void xcd_barrier(const XcdBarrier& b) {
    asm volatile("s_waitcnt vmcnt(0)" ::: "memory");
    __syncthreads();
    if (threadIdx.x == 0) {
        unsigned* bar = b.bar;
        const unsigned bx_ = (unsigned)__builtin_amdgcn_readfirstlane((int)xb_xcc_id());
        __builtin_amdgcn_s_waitcnt(0);
        unsigned nloc = b.st[0], nx = b.st[1];
        if (nloc == 0u) { xcd_barrier_complete(bar, bx_, nloc, nx); b.st[0] = nloc; b.st[1] = nx; }
        const unsigned old = xb_add(&bar[XB_XSUB(bx_)], 1u);
        const unsigned gen = old / nloc;
        if (old + 1u == (gen + 1u) * nloc) {
            __builtin_amdgcn_fence(__ATOMIC_RELEASE, "agent");
            asm volatile("s_waitcnt vmcnt(0)" ::: "memory");
            const unsigned og = xb_add(&bar[XB_TOP], 1u);
            const unsigned tg = og / nx;
            if (og + 1u == (tg + 1u) * nx) xb_add(&bar[XB_TOPGEN], 1u);
            else XB_SPIN(xb_ld(&bar[XB_TOPGEN]) == tg, bar);
            __builtin_amdgcn_fence(__ATOMIC_ACQUIRE, "agent");
            xb_add(&bar[XB_XGEN(bx_)], 1u);
            asm volatile("s_waitcnt vmcnt(0)" ::: "memory");
        } else {
            XB_SPIN(xb_ld(&bar[XB_XGEN(bx_)]) == gen, bar);
            __builtin_amdgcn_fence(__ATOMIC_ACQUIRE, "agent");
            asm volatile("s_waitcnt vmcnt(0)" ::: "memory");
        }
    }
    __syncthreads();
}

__device__ __forceinline__ void signal_done(unsigned* cnt) {
    asm volatile("s_waitcnt vmcnt(0)" ::: "memory");
    __syncthreads();
    if (threadIdx.x == 0) {
        __builtin_amdgcn_fence(__ATOMIC_RELEASE, "agent");
        asm volatile("s_waitcnt vmcnt(0)" ::: "memory");
        (void)__hip_atomic_fetch_add(cnt, 1u, __ATOMIC_RELAXED, __HIP_MEMORY_SCOPE_AGENT);
    }
}
__device__ __forceinline__ void wait_count(unsigned* cnt, unsigned need) {
    if (threadIdx.x == 0) {
        unsigned sp = 0;
        while (__hip_atomic_load(cnt, __ATOMIC_RELAXED, __HIP_MEMORY_SCOPE_AGENT) < need) { __builtin_amdgcn_s_sleep(2); if (++sp > (1u << 22)) break; }
        __builtin_amdgcn_fence(__ATOMIC_ACQUIRE, "agent");
        asm volatile("s_waitcnt vmcnt(0)" ::: "memory");
    }
    __syncthreads();
}

constexpr int BM = 256, BK = 64, HALF = 128, HTB = HALF * BK * 2;
__device__ __forceinline__ int lds_byte(int r, int c) { const int st = (r >> 4) * 2 + (c >> 5), rr = r & 15, cc = c & 31, ob = rr * 64 + cc * 2; return st * 1024 + (ob ^ (((ob >> 9) & 1) << 5)); }
__device__ __forceinline__ void stage_rc(int b, int& R, int& C) { const int st = b / 1024, sb = b % 1024, swz = sb ^ (((sb >> 9) & 1) << 5); R = (st >> 1) * 16 + swz / 64; C = (st & 1) * 32 + (swz % 64) / 2; }
struct Unit { int pm, pn; };
struct Gemm { const bf16_t* A; const bf16_t* Bt; int K; };
struct Sched {
    int nM, nN, nwg, G, c; int fpm = -1, fpn = 0;
    __device__ __forceinline__ void init(int nM_, int nN_, int G_, int c_) { nM = nM_; nN = nN_; nwg = nM * nN; G = G_; c = c_; fpm = -1; }
    __device__ __forceinline__ void init_single(int pm, int pn) { nM = nN = nwg = 1; G = 1; c = 0; fpm = pm; fpn = pn; }
    __device__ __forceinline__ bool next(int i, Unit& u) const {
        if (fpm >= 0) { if (i > 0) return false; u.pm = fpm; u.pn = fpn; return true; }
        const long L = (long)i * G + c; if (L >= nwg) return false;
        int wgid = (int)L; { const int q = nwg / 8, r = nwg % 8, xcd = wgid % 8, off = wgid / 8; wgid = (xcd < r ? xcd * (q + 1) : r * (q + 1) + (xcd - r) * q) + off; }
        const int nig = 8 * nN, gid = wgid / nig, fm = gid * 8, gsz = (nM - fm) < 8 ? (nM - fm) : 8;
        u.pm = fm + ((wgid % nig) % gsz); u.pn = (wgid % nig) / gsz; return true;
    }
};
template <class Epi>
__device__ __forceinline__ void gemm_phase(const Gemm g, const Sched& S, const Epi& E) {
    LAS unsigned char* lds = (LAS unsigned char*)smem;
    const int tid = opaque_tid(), wid = __builtin_amdgcn_readfirstlane(tid >> 6), lane = tid & 63, wr = wid >> 2, wc = wid & 3, fr = lane & 15, fq = lane >> 4;
    const int K = g.K, nt = K / BK;
    unsigned voff[2];
#pragma unroll
    for (int i = 0; i < 2; ++i) { int R, C; stage_rc(tid * 16 + i * 8192, R, C); voff[i] = (unsigned)(R * K + C) * 2u; }
    const size_t kstep = (size_t)(BK * 2);
    const size_t hstep = (size_t)HALF * K * 2;
    const size_t tstep = 2 * hstep;
    const unsigned ldsw = (unsigned)wid * 1024u;
    const int aoff = lds_byte(wr * 64 + fr, fq * 8), boff = lds_byte(wc * 32 + fr, fq * 8);
#define PG8_SA(b, h) (((b) * 2 + (h)) * HTB)
#define PG8_SB(b, h) ((4 + (b) * 2 + (h)) * HTB)
#define PG8_STAGE(bufoff, gbase) do { _Pragma("unroll") for (int _i = 0; _i < 2; ++_i) \
        __builtin_amdgcn_global_load_lds((const unsigned*)((const char*)(gbase) + voff[_i]), (LAS unsigned*)(lds + (bufoff) + ldsw + _i * 8192), 16, 0, 0); } while (0)
#define PG8_LDA(dst, b, h) do { _Pragma("unroll") for (int m = 0; m < 4; ++m) _Pragma("unroll") for (int k = 0; k < 2; ++k) dst[m][k] = *(const LAS bf16x8*)(lds + PG8_SA(b, h) + aoff + m * 2048 + k * 1024); } while (0)
#define PG8_LDB(dst, b, h) do { _Pragma("unroll") for (int n = 0; n < 2; ++n) _Pragma("unroll") for (int k = 0; k < 2; ++k) dst[n][k] = *(const LAS bf16x8*)(lds + PG8_SB(b, h) + boff + n * 2048 + k * 1024); } while (0)
#define PG8_MMA(ai, bj, At, Bq) do { __builtin_amdgcn_s_setprio(1); _Pragma("unroll") for (int m = 0; m < 4; ++m) _Pragma("unroll") for (int n = 0; n < 2; ++n) _Pragma("unroll") for (int k = 0; k < 2; ++k) \
        acc[ai][bj][m][n] = __builtin_amdgcn_mfma_f32_16x16x32_bf16(Bq[n][k], At[m][k], acc[ai][bj][m][n], 0, 0, 0); __builtin_amdgcn_s_setprio(0); } while (0)
#define PG8_WAIT_V(n) asm volatile("s_waitcnt vmcnt(" #n ")" ::: "memory")
#define PG8_WAIT_L(n) asm volatile("s_waitcnt lgkmcnt(" #n ")" ::: "memory")
#define PG8_BAR __builtin_amdgcn_s_barrier()
#define PG8_SCHED __builtin_amdgcn_sched_barrier(0)
    Unit cur, nxt; int ui = 0;
    if (!S.next(0, cur)) return;
    f32x4 acc[2][2][4][2];
    if constexpr (Epi::INIT) E.init(acc, cur.pm * BM + wr * 64 + fr, cur.pn * BM + wc * 32 + 8 * fq);
    else {
#pragma unroll
        for (int a = 0; a < 2; ++a)
#pragma unroll
            for (int b = 0; b < 2; ++b)
#pragma unroll
                for (int m = 0; m < 4; ++m)
#pragma unroll
                    for (int n = 0; n < 2; ++n) acc[a][b][m][n] = (f32x4){0.f, 0.f, 0.f, 0.f};
    }
    bf16x8 At[4][2], B0[2][2], B1[2][2];
    const char* cA = (const char*)g.A + (size_t)cur.pm * tstep; const char* cB = (const char*)g.Bt + (size_t)cur.pn * tstep;
    PG8_STAGE(PG8_SB(0, 0), cB); PG8_STAGE(PG8_SA(0, 0), cA); PG8_STAGE(PG8_SB(0, 1), cB + hstep); PG8_STAGE(PG8_SA(0, 1), cA + hstep);
    if (wr == 1) PG8_BAR;
    PG8_WAIT_V(4); PG8_BAR;
    PG8_STAGE(PG8_SB(1, 0), cB + kstep); PG8_STAGE(PG8_SA(1, 0), cA + kstep); PG8_STAGE(PG8_SB(1, 1), cB + hstep + kstep);
    PG8_WAIT_V(6); PG8_BAR;
    for (;;) {
        const bool has_next = S.next(ui + 1, nxt);
        const char* nA = has_next ? (const char*)g.A + (size_t)nxt.pm * tstep : cA; const char* nB = has_next ? (const char*)g.Bt + (size_t)nxt.pn * tstep : cB;
        for (int t = 0; t < nt; t += 2) {
            const bool last = (t == nt - 2);
            if constexpr (Epi::WAITK >= 0) { if (t == Epi::WAITK) E.wait_k(cur.pm, wid); }
            if constexpr (Epi::HOOK) { if (t == 8 || t == 16) E.hook(t, acc, cur.pm * BM + wr * 64 + fr, cur.pn * BM + wc * 32 + 8 * fq); }
            const char* a1 = cA + (size_t)(t + 1) * kstep;
            const char* a2 = last ? nA : cA + (size_t)(t + 2) * kstep; const char* b2 = last ? nB : cB + (size_t)(t + 2) * kstep;
            const char* a3 = a2 + kstep; const char* b3 = b2 + kstep;
            PG8_LDB(B0, 0, 0); PG8_SCHED; PG8_LDA(At, 0, 0); PG8_STAGE(PG8_SA(1, 1), a1 + hstep);
            PG8_WAIT_L(8); PG8_BAR; PG8_WAIT_L(0); PG8_MMA(0, 0, At, B0); PG8_BAR; PG8_SCHED;
            PG8_LDB(B1, 0, 1); PG8_STAGE(PG8_SB(0, 0), b2);
            PG8_BAR; PG8_WAIT_L(0); PG8_MMA(0, 1, At, B1); PG8_BAR;
            PG8_LDA(At, 0, 1); PG8_STAGE(PG8_SA(0, 0), a2);
            PG8_BAR; PG8_WAIT_L(0); PG8_MMA(1, 0, At, B0); PG8_BAR; PG8_SCHED;
            PG8_STAGE(PG8_SB(0, 1), b2 + hstep);
            PG8_WAIT_V(6); PG8_BAR; PG8_MMA(1, 1, At, B1); PG8_BAR;
            PG8_LDB(B0, 1, 0); PG8_SCHED; PG8_LDA(At, 1, 0); PG8_STAGE(PG8_SA(0, 1), a2 + hstep);
            PG8_WAIT_L(8); PG8_BAR; PG8_WAIT_L(0); PG8_MMA(0, 0, At, B0); PG8_BAR; PG8_SCHED;
            PG8_LDB(B1, 1, 1); PG8_STAGE(PG8_SB(1, 0), b3);
            PG8_BAR; PG8_WAIT_L(0); PG8_MMA(0, 1, At, B1); PG8_BAR;
            PG8_LDA(At, 1, 1); PG8_STAGE(PG8_SA(1, 0), a3);
            PG8_BAR; PG8_WAIT_L(0); PG8_MMA(1, 0, At, B0); PG8_BAR; PG8_SCHED;
            PG8_STAGE(PG8_SB(1, 1), b3 + hstep);
            PG8_WAIT_V(6); PG8_BAR; PG8_MMA(1, 1, At, B1); PG8_BAR;
        }
        asm volatile("s_nop 15\n\ts_nop 15" ::: "memory");
        E(acc, cur.pm * BM + wr * 64 + fr, cur.pn * BM + wc * 32 + 8 * fq);
        if (!has_next) break;
        cur = nxt; cA = nA; cB = nB; ++ui;
        if constexpr (Epi::INIT) E.init(acc, cur.pm * BM + wr * 64 + fr, cur.pn * BM + wc * 32 + 8 * fq);
        else {
#pragma unroll
            for (int a = 0; a < 2; ++a)
#pragma unroll
                for (int b = 0; b < 2; ++b)
#pragma unroll
                    for (int m = 0; m < 4; ++m)
#pragma unroll
                        for (int n = 0; n < 2; ++n) acc[a][b][m][n] = (f32x4){0.f, 0.f, 0.f, 0.f};
        }
    }
    PG8_WAIT_V(0);
    if (wr == 0) PG8_BAR;
    PG8_BAR;
#undef PG8_SA
#undef PG8_SB
#undef PG8_STAGE
#undef PG8_LDA
#undef PG8_LDB
#undef PG8_MMA
#undef PG8_WAIT_V
#undef PG8_WAIT_L
#undef PG8_BAR
#undef PG8_SCHED
}

__device__ __forceinline__ u32x2 pack4(f32x4 v) { u32x2 w; w.x = cvt_pk_bf16(v[0], v[1]); w.y = cvt_pk_bf16(v[2], v[3]); return w; }

__device__ __forceinline__ int perm_row(int c) { const int x = c & 31; return (c & ~31) + 16 * ((x >> 2) & 1) + 4 * (x >> 3) + (x & 3); }
__device__ __forceinline__ int glu_col(int c) {
    if (c < 1024 || c >= 2048) return c;
    const int ch = (c - 1024) & 511, isg = (c - 1024) >> 9;
    return 1024 + 256 * (ch >> 7) + 128 * isg + (ch & 127);
}
__device__ __forceinline__ void transpose_convert_tile(const float* __restrict__ src, int K, int N, bf16_t* __restrict__ dst, int ldd, int item, bool glu_remap) {
    float* tile = (float*)smem;
    const int ntn = N / 256, tk = item / ntn, tn = item % ntn, t = opaque_tid();
    {
        const int n = t & 255, k0 = t >> 8;
        const float* sp = src + (size_t)(tk * 64 + k0) * N + tn * 256 + n;
        float v[32];
#pragma unroll
        for (int i = 0; i < 32; ++i) v[i] = sp[(size_t)(2 * i) * N];
#pragma unroll
        for (int i = 0; i < 32; ++i) tile[(k0 + 2 * i) * 257 + n] = v[i];
    }
    __syncthreads();
    {
        const int k4 = (t & 15) * 4, n0 = t >> 4;
#pragma unroll
        for (int i = 0; i < 8; ++i) {
            const int n = n0 + 32 * i;
            u32x2 w;
            w.x = cvt_pk_bf16(tile[k4 * 257 + n], tile[(k4 + 1) * 257 + n]);
            w.y = cvt_pk_bf16(tile[(k4 + 2) * 257 + n], tile[(k4 + 3) * 257 + n]);
            *(u32x2*)(dst + (size_t)perm_row(glu_remap ? glu_col(tn * 256 + n) : tn * 256 + n) * ldd + tk * 64 + k4) = w;
        }
    }
    __syncthreads();
}

__device__ __forceinline__ void norm_row_bf16(const float* __restrict__ src, const float* __restrict__ g, bf16_t* __restrict__ dst, int lane) {
    f32x4 v[4]; float ss = 0.f;
#pragma unroll
    for (int i = 0; i < 4; ++i) { v[i] = *(const f32x4*)(src + i * 256 + lane * 4); ss += v[i][0] * v[i][0] + v[i][1] * v[i][1] + v[i][2] * v[i][2] + v[i][3] * v[i][3]; }
    ss = wave_sum(ss);
    const float rstd = rsqrtf(ss * (1.0f / 1024.0f) + EPS);
#pragma unroll
    for (int i = 0; i < 4; ++i) {
        const f32x4 gg = *(const f32x4*)(g + i * 256 + lane * 4);
        *(u32x2*)(dst + i * 256 + lane * 4) = pack4(v[i] * rstd * gg);
    }
}
__device__ __forceinline__ void norm_row_f32(const float* __restrict__ src, const float* __restrict__ g, float* __restrict__ dst, int lane) {
    f32x4 v[4]; float ss = 0.f;
#pragma unroll
    for (int i = 0; i < 4; ++i) { v[i] = *(const f32x4*)(src + i * 256 + lane * 4); ss += v[i][0] * v[i][0] + v[i][1] * v[i][1] + v[i][2] * v[i][2] + v[i][3] * v[i][3]; }
    ss = wave_sum(ss);
    const float rstd = rsqrtf(ss * (1.0f / 1024.0f) + EPS);
#pragma unroll
    for (int i = 0; i < 4; ++i) {
        const f32x4 gg = *(const f32x4*)(g + i * 256 + lane * 4);
        *(f32x4*)(dst + i * 256 + lane * 4) = v[i] * rstd * gg;
    }
}

__device__ __forceinline__ const float* xrow_ptr(const Params& p, int l, int row) {
    if (l == 0) return row < TP ? IN(I_XP) + (size_t)row * DM : IN(I_XS) + (size_t)(row - TP) * DM;
    return (const float*)(WS(p) + W_XN) + (size_t)row * DM;
}

__device__ __forceinline__ void phase_norm(const Params& p, int l) {
    const int w = opaque_tid() >> 6, lane = opaque_tid() & 63;
    bf16_t* Hb = (bf16_t*)(WS(p) + W_H);
    for (int row = blockIdx.x * 8 + w; row < MP; row += gridDim.x * 8) {
        if (row < TT) norm_row_bf16(xrow_ptr(p, l, row), IN(I_NORMG) + l * DM, Hb + (size_t)row * DM, lane);
        else {
#pragma unroll
            for (int i = 0; i < 4; ++i) *(u32x2*)(Hb + (size_t)row * DM + i * 256 + lane * 4) = (u32x2){0u, 0u};
        }
    }
}

__device__ __forceinline__ void convert_weights(const Params& p, int stage, int b0, int nb) {
    const int srcs[8] = {I_WIN, I_WGLU, I_WBRC, I_WBRX, I_WBRS, I_WK, I_WV, I_WOUT};
    const int Ks[8] = {1024, 512, 512, 512, 512, 1024, 1024, 1024};
    const int Ns[8] = {ZW, 512, 1024, 1024, 1024, 512, 512, 1024};
    const int ldds[8] = {1024, 512, 1536, 1536, 1536, 1024, 1024, 1024};
    const size_t offs[8] = {WT_IN, WT_GLU, WT_BR, WT_BR + 512, WT_BR + 1024, WT_K, WT_V, WT_OUT};
    if ((int)blockIdx.x < b0 || (int)blockIdx.x >= b0 + nb) return;
    int base = 0;
#pragma unroll
    for (int l = 0; l < 2; ++l)
#pragma unroll
        for (int i = 0; i < 8; ++i) {
            const bool early = ((i == 0 || i == 1) && l == 0) || i == 5 || i == 6;
            if (early != (stage == 0)) continue;
            const int nt = (Ks[i] / 64) * (Ns[i] / 256);
            const float* src = IN(srcs[i]) + (size_t)l * Ks[i] * Ns[i];
            bf16_t* dst = (bf16_t*)(WS(p) + W_WT) + l * WT_LAYER + offs[i];
            const unsigned G_ = (unsigned)nb; const int first = (int)(((unsigned)((int)blockIdx.x - b0) + G_ - (unsigned)base % G_) % G_);
            for (int it = first; it < nt; it += nb) transpose_convert_tile(src, Ks[i], Ns[i], dst, ldds[i], it, i == 0);
            base += nt;
        }
}
__device__ __forceinline__ void phase_prep(const Params& p) {
    convert_weights(p, 0, 0, gridDim.x);
    const int w = opaque_tid() >> 6, lane = opaque_tid() & 63;
    for (int r = blockIdx.x * 8 + w; r < 2 * 2048; r += gridDim.x * 8) {
        const int l = r >> 11, row = r & 2047;
        norm_row_bf16(IN(I_MEM) + (size_t)row * DM, IN(I_MEMG) + l * DM, (bf16_t*)(WS(p) + W_HM) + (size_t)r * DM, lane);
    }
    phase_norm(p, 0);
}

__device__ __forceinline__ int in_act(int col) {
    if (col < 512) return 0; if (col < 1024) return 1; if (col < 2048) return 3;
    if (col < 2560) return 1; if (col < 3072) return 0; if (col < 3584) return 1; return 2;
}
typedef f32x4 Acc[2][2][4][2];
#define FOR_AI  _Pragma("unroll") for (int ai = 0; ai < 2; ++ai)
#define FOR_MB _Pragma("unroll") for (int m = 0; m < 4; ++m) _Pragma("unroll") for (int bj = 0; bj < 2; ++bj)
__device__ __forceinline__ u32x4 pack8(f32x4 a, f32x4 b) { u32x4 w; w.x = cvt_pk_bf16(a[0], a[1]); w.y = cvt_pk_bf16(a[2], a[3]); w.z = cvt_pk_bf16(b[0], b[1]); w.w = cvt_pk_bf16(b[2], b[3]); return w; }
__device__ __forceinline__ f32x4 unlo(u32x4 w) { return (f32x4){bflo(w.x), bfhi(w.x), bflo(w.y), bfhi(w.y)}; }
__device__ __forceinline__ f32x4 unhi(u32x4 w) { return (f32x4){bflo(w.z), bfhi(w.z), bflo(w.w), bfhi(w.w)}; }
__device__ __forceinline__ f32x4 sig4(f32x4 v) { return (f32x4){sigmoidf_(v[0]), sigmoidf_(v[1]), sigmoidf_(v[2]), sigmoidf_(v[3])}; }
__device__ __forceinline__ f32x4 silu4(f32x4 v) { return (f32x4){siluf_(v[0]), siluf_(v[1]), siluf_(v[2]), siluf_(v[3])}; }
__device__ __forceinline__ f32x4 gcl4(f32x4 v) { return (f32x4){fmaxf(v[0], 1e-30f), fmaxf(v[1], 1e-30f), fmaxf(v[2], 1e-30f), fmaxf(v[3], 1e-30f)}; }
__device__ __forceinline__ f32x4 rcp4(f32x4 v) { return (f32x4){__builtin_amdgcn_rcpf(v[0]), __builtin_amdgcn_rcpf(v[1]), __builtin_amdgcn_rcpf(v[2]), __builtin_amdgcn_rcpf(v[3])}; }
struct EpiIn {
    static constexpr bool HOOK = false, INIT = false; static constexpr int WAITK = -1;
    bf16_t* Z;
    __device__ __forceinline__ void operator()(Acc& acc, int row0, int col0) const {
        const int act = in_act(col0);
        if (act == 3) {
            const int vcol = C_UB + (((col0 & ~255) - 1024) >> 1) + (col0 & 255);
            FOR_AI {
#pragma unroll
                for (int m = 0; m < 4; ++m)
                    *(u32x4*)(Z + zoff(row0 + ai * 128 + m * 16, vcol)) = pack8(acc[ai][0][m][0] * sig4(acc[ai][1][m][0]), acc[ai][0][m][1] * sig4(acc[ai][1][m][1]));
            }
            return;
        }
        FOR_AI FOR_MB {
            f32x4 v0 = acc[ai][bj][m][0], v1 = acc[ai][bj][m][1];
            if (act == 1) { v0 = silu4(v0); v1 = silu4(v1); }
            else if (act == 2) { v0 = sig4(v0); v1 = sig4(v1); }
            *(u32x4*)(Z + zoff(row0 + ai * 128 + m * 16, col0 + bj * 128)) = pack8(v0, v1);
        }
    }
};
struct EpiKV {
    static constexpr bool HOOK = false, INIT = false; static constexpr int WAITK = -1;
    float* outf; bf16_t* kb; bf16_t* vt; int isV;
    __device__ __forceinline__ void operator()(Acc& acc, int row0, int col0) const {
        FOR_AI FOR_MB {
            const f32x4 v0 = acc[ai][bj][m][0], v1 = acc[ai][bj][m][1];
            const int row = row0 + ai * 128 + m * 16, col = col0 + bj * 128;
            *(f32x4*)(outf + (size_t)row * 512 + col) = v0; *(f32x4*)(outf + (size_t)row * 512 + col + 4) = v1;
            if (!isV) *(u32x4*)(kb + (size_t)row * 512 + col) = pack8(v0, v1);
            else {
                const int b = row >> 8, mm = row & 255, head = col >> 7, d = col & 127;
                bf16_t* q = vt + ((size_t)((b * 4 + head) * 128 + d)) * 256 + mm;
                q[0] = f2bf(v0[0]); q[256] = f2bf(v0[1]); q[512] = f2bf(v0[2]); q[768] = f2bf(v0[3]);
                q[1024] = f2bf(v1[0]); q[1280] = f2bf(v1[1]); q[1536] = f2bf(v1[2]); q[1792] = f2bf(v1[3]);
            }
        }
    }
};
struct EpiGlu {
    static constexpr bool HOOK = false, INIT = false; static constexpr int WAITK = -1;
    const bf16_t* Ya; const bf16_t* Z; const float* bias; bf16_t* ABR;
    __device__ __forceinline__ void operator()(Acc& acc, int row0, int col0) const {
        f32x4 bv[2][2];
#pragma unroll
        for (int bj = 0; bj < 2; ++bj) { bv[bj][0] = *(const f32x4*)(bias + col0 + bj * 128); bv[bj][1] = *(const f32x4*)(bias + col0 + bj * 128 + 4); }
        FOR_AI {
            u32x4 ya[4][2], za[4][2];
            FOR_MB {
                const int row = row0 + ai * 128 + m * 16, col = col0 + bj * 128;
                ya[m][bj] = *(const u32x4*)(Ya + (size_t)row * 512 + col);
                za[m][bj] = *(const u32x4*)(Z + zoff(row, C_ZA + col));
            }
            FOR_MB {
                const int row = row0 + ai * 128 + m * 16, col = col0 + bj * 128;
                const f32x4 o0 = unlo(ya[m][bj]) * sig4(acc[ai][bj][m][0] + bv[bj][0]) * unlo(za[m][bj]);
                const f32x4 o1 = unhi(ya[m][bj]) * sig4(acc[ai][bj][m][1] + bv[bj][1]) * unhi(za[m][bj]);
                *(u32x4*)(ABR + (size_t)row * 1536 + 1024 + col) = pack8(o0, o1);
            }
        }
    }
};
__device__ __forceinline__ float gclamp(float g) { return fmaxf(g, 1e-30f); }
struct EpiBr3 {
    static constexpr bool HOOK = true, INIT = false; static constexpr int WAITK = 14;
    const bf16_t* Z; bf16_t* Mb; unsigned* cnt;
    __device__ __forceinline__ void wait_k(int pm, int wid) const {
        if (wid == 0) {
            if ((threadIdx.x & 63) == 0) { unsigned sp = 0; while (__hip_atomic_load(cnt + pm, __ATOMIC_RELAXED, __HIP_MEMORY_SCOPE_AGENT) < 2u) { __builtin_amdgcn_s_sleep(2); if (++sp > (1u << 22)) break; } }
            __builtin_amdgcn_fence(__ATOMIC_ACQUIRE, "agent");
            asm volatile("s_waitcnt vmcnt(0)" ::: "memory");
        }
        asm volatile("" ::: "memory"); __builtin_amdgcn_s_barrier(); asm volatile("" ::: "memory");
    }
    __device__ __forceinline__ void hook(int t, Acc& acc, int row0, int col0) const {
        const int cn = (t == 8) ? C_GB : C_GX, cd = (t == 8) ? C_GX : C_GA;
        asm volatile("" : "+v"(row0));
        const char* Zc = (const char*)Z;
        FOR_AI {
            u32x4 gn[4][2], gd[4][2];
            FOR_MB {
                const size_t o = zoff(row0 + ai * 128 + m * 16, col0 + bj * 128) * 2;
                gn[m][bj] = *(const u32x4*)(Zc + o + zoff(0, cn) * 2); gd[m][bj] = *(const u32x4*)(Zc + o + zoff(0, cd) * 2);
            }
            FOR_MB {
                acc[ai][bj][m][0] *= gcl4(unlo(gn[m][bj])) * rcp4(gcl4(unlo(gd[m][bj])));
                acc[ai][bj][m][1] *= gcl4(unhi(gn[m][bj])) * rcp4(gcl4(unhi(gd[m][bj])));
            }
        }
    }
    __device__ __forceinline__ void operator()(Acc& acc, int row0, int col0) const {
        FOR_AI {
            u32x4 ga[4][2];
            FOR_MB ga[m][bj] = *(const u32x4*)(Z + zoff(row0 + ai * 128 + m * 16, C_GA + col0 + bj * 128));
            FOR_MB {
                const f32x4 v0 = acc[ai][bj][m][0] * gcl4(unlo(ga[m][bj])), v1 = acc[ai][bj][m][1] * gcl4(unhi(ga[m][bj]));
                *(u32x4*)(Mb + (size_t)(row0 + ai * 128 + m * 16) * DM + col0 + bj * 128) = pack8(v0, v1);
            }
        }
    }
};
struct EpiOut {
    static constexpr bool HOOK = false, INIT = true; static constexpr int WAITK = -1;
    const float* src; float* dst;
    __device__ __forceinline__ void init(Acc& acc, int row0, int col0) const {
        FOR_AI FOR_MB {
            const float* q = src + (size_t)(row0 + ai * 128 + m * 16) * DM + col0 + bj * 128;
            acc[ai][bj][m][0] = *(const f32x4*)q; acc[ai][bj][m][1] = *(const f32x4*)(q + 4);
        }
    }
    __device__ __forceinline__ void operator()(Acc& acc, int row0, int col0) const {
        FOR_AI FOR_MB {
            float* q = dst + (size_t)(row0 + ai * 128 + m * 16) * DM + col0 + bj * 128;
            *(f32x4*)q = acc[ai][bj][m][0]; *(f32x4*)(q + 4) = acc[ai][bj][m][1];
        }
    }
};

__device__ __forceinline__ void phase_inproj(const Params& p, int l) {
    const bf16_t* Hb = (const bf16_t*)(WS(p) + W_H);
    const bf16_t* Wt = (const bf16_t*)(WS(p) + W_WT) + l * WT_LAYER;
    bf16_t* Z = (bf16_t*)(WS(p) + W_Z);
    const int G = gridDim.x;
    {
        Sched S; S.init(MP / 256, ZW / 256, G, blockIdx.x);
        EpiIn e{Z};
        gemm_phase(Gemm{Hb, Wt + WT_IN, DM}, S, e);
    }
    if (l == 0) {
#pragma unroll 1
        for (int k = 0; k < 4; ++k) {
            const int ll = k >> 1, isV = k & 1;
            const int c = (int)((blockIdx.x + 4u * G - 154u - 16u * k) % (unsigned)G);
            Sched S; S.init(8, 2, G, c);
            const bf16_t* Hm = (const bf16_t*)(WS(p) + W_HM) + (size_t)ll * 2048 * DM;
            const bf16_t* W = (const bf16_t*)(WS(p) + W_WT) + ll * WT_LAYER + (isV ? WT_V : WT_K);
            EpiKV e{OUTP() + (isV ? O_PV : O_PK) + (size_t)ll * 2048 * 512, (bf16_t*)(WS(p) + W_KB) + (size_t)ll * 2048 * 512, (bf16_t*)(WS(p) + W_VT) + (size_t)ll * 2048 * 512, isV};
            gemm_phase(Gemm{Hm, W, DM}, S, e);
        }
    }
}

__device__ __forceinline__ void phase_glu(const Params& p, int l) {
    const bf16_t* Wt = (const bf16_t*)(WS(p) + W_WT) + l * WT_LAYER;
    Sched S; S.init(MP / 256, 2, gridDim.x, blockIdx.x);
    EpiGlu e{(const bf16_t*)(WS(p) + W_YA), (const bf16_t*)(WS(p) + W_Z), IN(I_BGLU) + l * 512, (bf16_t*)(WS(p) + W_ABR)};
    gemm_phase(Gemm{(const bf16_t*)(WS(p) + W_YA), Wt + WT_GLU, 512}, S, e);
}
template <int K, bool HOOKS, class Epi>
__device__ __forceinline__ void skinny_gemm(const bf16_t* __restrict__ A, const bf16_t* __restrict__ Bt, int cb, const Epi& E) {
    const int tid = opaque_tid(), w = tid >> 6, lane = tid & 63, fr = lane & 15, fq = lane >> 4;
    const bf16_t* ap = A + (size_t)(16 * w + fr) * K + 8 * fq;
    const bf16_t* bp = Bt + (size_t)(16 * cb + fr) * K + 8 * fq;
    f32x4 acc = {0.f, 0.f, 0.f, 0.f};
#pragma unroll 1
    for (int k0 = 0; k0 < K; k0 += 512) {
        if constexpr (HOOKS) { if (k0 == 512 || k0 == 1024) E.hook(k0, acc, 16 * w + fr, 32 * (cb >> 1) + 8 * fq + 4 * (cb & 1)); }
        bf16x8 af[16], bf[16];
#pragma unroll
        for (int i = 0; i < 16; ++i) { af[i] = *(const bf16x8*)(ap + k0 + 32 * i); bf[i] = *(const bf16x8*)(bp + k0 + 32 * i); }
#pragma unroll
        for (int i = 0; i < 16; ++i) acc = __builtin_amdgcn_mfma_f32_16x16x32_bf16(bf[i], af[i], acc, 0, 0, 0);
    }
    E(acc, 16 * w + fr, 32 * (cb >> 1) + 8 * fq + 4 * (cb & 1));
}
struct EpiBrS {
    const bf16_t* Z; bf16_t* Mb;
    __device__ __forceinline__ void hook(int k0, f32x4& acc, int r, int col) const {
        const int cn = (k0 == 512) ? C_GB : C_GX, cd = (k0 == 512) ? C_GX : C_GA;
        const u32x2 a = *(const u32x2*)(Z + zoff(TP + r, cn + col)), d = *(const u32x2*)(Z + zoff(TP + r, cd + col));
        acc[0] *= gclamp(bflo(a.x)) * __builtin_amdgcn_rcpf(gclamp(bflo(d.x))); acc[1] *= gclamp(bfhi(a.x)) * __builtin_amdgcn_rcpf(gclamp(bfhi(d.x)));
        acc[2] *= gclamp(bflo(a.y)) * __builtin_amdgcn_rcpf(gclamp(bflo(d.y))); acc[3] *= gclamp(bfhi(a.y)) * __builtin_amdgcn_rcpf(gclamp(bfhi(d.y)));
    }
    __device__ __forceinline__ void operator()(f32x4 acc, int r, int col) const {
        const u32x2 a = *(const u32x2*)(Z + zoff(TP + r, C_GA + col));
        acc[0] *= gclamp(bflo(a.x)); acc[1] *= gclamp(bfhi(a.x)); acc[2] *= gclamp(bflo(a.y)); acc[3] *= gclamp(bfhi(a.y));
        *(u32x2*)(Mb + (size_t)(TP + r) * DM + col) = pack4(acc);
    }
};
struct EpiOutS {
    const float* src; float* dst;
    __device__ __forceinline__ void operator()(f32x4 acc, int r, int col) const {
        *(f32x4*)(dst + (size_t)r * DM + col) = *(const f32x4*)(src + (size_t)r * DM + col) + acc;
    }
};
__device__ __forceinline__ void phase_glu_br(const Params& p, int l) {
    const bf16_t* Wt = (const bf16_t*)(WS(p) + W_WT) + l * WT_LAYER;
    const int G = gridDim.x, bx = blockIdx.x;
    unsigned* cnt = (unsigned*)(WS(p) + W_CNT) + l * 80;
#pragma unroll 1
    for (int u = bx; u < 130; u += G) {
        Sched S; S.init_single(u >> 1, u & 1);
        EpiGlu e{(const bf16_t*)(WS(p) + W_YA), (const bf16_t*)(WS(p) + W_Z), IN(I_BGLU) + l * 512, (bf16_t*)(WS(p) + W_ABR)};
        gemm_phase(Gemm{(const bf16_t*)(WS(p) + W_YA), Wt + WT_GLU, 512}, S, e);
        signal_done(cnt + (u >> 1));
    }
    {
        Sched S; S.init(TP / 256, 4, G, bx);
        EpiBr3 e{(const bf16_t*)(WS(p) + W_Z), (bf16_t*)(WS(p) + W_H), cnt};
        gemm_phase(Gemm{(const bf16_t*)(WS(p) + W_ABR), Wt + WT_BR, 1536}, S, e);
    }
#pragma unroll 1
    for (int cb = (int)((bx + 64u * (unsigned)G - (unsigned)(G >= 64 ? G - 64 : 0)) % (unsigned)G); cb < 64; cb += G) {
        wait_count(cnt + 64, 2u);
        EpiBrS e{(const bf16_t*)(WS(p) + W_Z), (bf16_t*)(WS(p) + W_H)};
        skinny_gemm<1536, true>((const bf16_t*)(WS(p) + W_ABR) + (size_t)TP * 1536, Wt + WT_BR, cb, e);
    }
}
__device__ __forceinline__ void phase_out(const Params& p, int l) {
    const bf16_t* Wt = (const bf16_t*)(WS(p) + W_WT) + l * WT_LAYER;
    {
        Sched S; S.init(TP / 256, 4, gridDim.x, blockIdx.x);
        EpiOut e{l == 0 ? IN(I_XP) : (const float*)(WS(p) + W_XN), (float*)(WS(p) + W_XN)};
        gemm_phase(Gemm{(const bf16_t*)(WS(p) + W_H), Wt + WT_OUT, DM}, S, e);
    }
    for (int cb = blockIdx.x; cb < 64; cb += gridDim.x) {
        float* xs_new = (float*)(WS(p) + W_XN) + (size_t)TP * DM;
        EpiOutS e{l == 0 ? IN(I_XS) : (const float*)xs_new, xs_new};
        skinny_gemm<1024, false>((const bf16_t*)(WS(p) + W_H) + (size_t)TP * DM, Wt + WT_OUT, cb, e);
    }
}
__device__ __forceinline__ void phase_final(const Params& p) {
    const int w = opaque_tid() >> 6, lane = opaque_tid() & 63;
    const float* xn = (const float*)(WS(p) + W_XN);
    for (int row = blockIdx.x * 8 + w; row < TT; row += gridDim.x * 8)
        norm_row_f32(xn + (size_t)row * DM, IN(I_FING), OUTP() + (row < TP ? O_YP + (size_t)row * DM : O_YS + (size_t)(row - TP) * DM), lane);
}

struct SsmCoef { float lr, li, cr, ci; };
__device__ __forceinline__ SsmCoef ssm_coef(const Params& p, int l, int g, int pp) {
    const float are = IN(I_ARE)[(l * 32 + g) * 64 + pp], aim = IN(I_AIM)[(l * 32 + g) * 64 + pp];
    const float dt = expf(IN(I_LOGDT)[l * 32 + g]);
    const float er = expf(are * dt);
    const double x = (double)aim * (double)dt;
    const double k = rint(x * 0.15915494309189535);
    const float r = (float)(x - k * 6.283185307179586);
    const float sn = sinf(r), cs = cosf(r);
    SsmCoef c; c.lr = er * cs; c.li = er * sn;
    const float nr = c.lr - 1.0f, ni = c.li, den = 1.0f / (are * are + aim * aim);
    c.cr = (nr * are + ni * aim) * den; c.ci = (ni * are - nr * aim) * den;
    return c;
}

constexpr int SSM_BPS = 528, SSM_CPS = 272;
constexpr int SSM_KM = 75776, SSM_BB = SSM_KM + 17 * 256 * 2, SSM_SIN = SSM_BB + 16 * 272, SSM_FIN = SSM_SIN + 8 * 16 * 272;
__device__ __forceinline__ void ssm_prompt_task(const Params& p, int l, int b, int g) {
    const int tid = opaque_tid(), w = tid >> 6, lane = tid & 63, fr = lane & 15, fq = lane >> 4;
    LAS unsigned char* RA = (LAS unsigned char*)smem;
    LAS unsigned char* KmL = (LAS unsigned char*)smem + SSM_KM;
    LAS unsigned char* BbT = (LAS unsigned char*)smem + SSM_BB;
    LAS unsigned char* SinL = (LAS unsigned char*)smem + SSM_SIN + w * (16 * 272);
    LAS float* fin = (LAS float*)((LAS unsigned char*)smem + SSM_FIN);
    const bf16_t* Z = (const bf16_t*)(WS(p) + W_Z);
    bf16_t* Ya = (bf16_t*)(WS(p) + W_YA);
    const size_t zrow0 = (size_t)b * SEQ + w * 256;
    bf16x8 uf[8];
#pragma unroll
    for (int s8 = 0; s8 < 8; ++s8) uf[s8] = *(const bf16x8*)(Z + zoff(zrow0 + 16 * fr + 2 * s8 + (fq >> 1), C_UA + g * 16 + 8 * (fq & 1)));
    float ccr[16], cci[16];
    {
        const float* crp = IN(I_CRE) + ((size_t)(l * 32 + g) * 16) * 64 + lane;
        const float* cip = IN(I_CIM) + ((size_t)(l * 32 + g) * 16) * 64 + lane;
#pragma unroll
        for (int h = 0; h < 16; ++h) { ccr[h] = crp[h * 64]; cci[h] = cip[h * 64]; }
    }
    const f32x4 dv = *(const f32x4*)(IN(I_D) + l * 512 + g * 16 + 4 * fq);
    const SsmCoef me = ssm_coef(p, l, g, lane);
    {
        const float* brp = IN(I_BRE) + ((size_t)(l * 32 + g) * 64 + lane) * 16;
        const float* bip = IN(I_BIM) + ((size_t)(l * 32 + g) * 64 + lane) * 16;
        float bbr[16], bbi[16];
#pragma unroll
        for (int q4 = 0; q4 < 4; ++q4) {
            const f32x4 vr = *(const f32x4*)(brp + 4 * q4), vi = *(const f32x4*)(bip + 4 * q4);
#pragma unroll
            for (int e = 0; e < 4; ++e) { bbr[4 * q4 + e] = me.cr * vr[e] - me.ci * vi[e]; bbi[4 * q4 + e] = me.cr * vi[e] + me.ci * vr[e]; }
        }
#pragma unroll
        for (int e = 0; e < 16; ++e) if ((e >> 1) == w) *(LAS unsigned*)(BbT + e * 272 + 4 * lane) = cvt_pk_bf16(bbr[e], bbi[e]);
        float qr = 1.f, qi = 0.f;
        for (int i2 = 0; i2 < 14 - 2 * w; ++i2) { const float a = qr * me.lr - qi * me.li, c2 = qr * me.li + qi * me.lr; qr = a; qi = c2; }
#pragma unroll
        for (int tsel = 0; tsel < 2; ++tsel) {
            const int tp = 2 * w + 1 - tsel;
            if (tsel == 1) { const float a = qr * me.lr - qi * me.li, c2 = qr * me.li + qi * me.lr; qr = a; qi = c2; }
#pragma unroll
            for (int e = 0; e < 16; e += 2) {
                const float r0 = qr * bbr[e] - qi * bbi[e], i0 = qr * bbi[e] + qi * bbr[e];
                const float r1 = qr * bbr[e + 1] - qi * bbi[e + 1], i1 = qr * bbi[e + 1] + qi * bbr[e + 1];
                *(LAS unsigned*)(RA + (2 * lane) * SSM_BPS + (16 * tp + e) * 2) = cvt_pk_bf16(r0, r1);
                *(LAS unsigned*)(RA + (2 * lane + 1) * SSM_BPS + (16 * tp + e) * 2) = cvt_pk_bf16(i0, i1);
            }
        }
    }
    __syncthreads();
    f32x4 a1[8];
    __builtin_amdgcn_s_setprio(1);
#pragma unroll
    for (int j = 0; j < 8; ++j) {
        f32x4 a = {0.f, 0.f, 0.f, 0.f};
#pragma unroll
        for (int s8 = 0; s8 < 8; ++s8) {
            const bf16x8 bf = *(const LAS bf16x8*)(RA + (16 * j + fr) * SSM_BPS + (32 * s8 + 8 * fq) * 2);
            a = __builtin_amdgcn_mfma_f32_16x16x32_bf16(uf[s8], bf, a, 0, 0, 0);
        }
        a1[j] = a;
    }
    __builtin_amdgcn_s_setprio(0);
    __syncthreads();
    LAS float* SL = (LAS float*)(RA + w * (16 * 132 * 4));
#pragma unroll
    for (int j = 0; j < 8; ++j)
#pragma unroll
        for (int r = 0; r < 4; ++r) SL[(4 * fq + r) * 132 + 16 * j + fr] = a1[j][r];
    float l16r = me.lr, l16i = me.li;
#pragma unroll
    for (int i2 = 0; i2 < 4; ++i2) { const float a = l16r * l16r - l16i * l16i, c2 = 2.f * l16r * l16i; l16r = a; l16i = c2; }
    float l256r = l16r, l256i = l16i;
#pragma unroll
    for (int i2 = 0; i2 < 4; ++i2) { const float a = l256r * l256r - l256i * l256i, c2 = 2.f * l256r * l256i; l256r = a; l256i = c2; }
    f32x2 sl[16];
#pragma unroll
    for (int sc = 0; sc < 16; ++sc) sl[sc] = *(const LAS f32x2*)(SL + sc * 132 + 2 * lane);
    {
        float er = 0.f, ei = 0.f;
#pragma unroll
        for (int sc = 0; sc < 16; ++sc) { const float a = l16r * er - l16i * ei + sl[sc].x, c2 = l16r * ei + l16i * er + sl[sc].y; er = a; ei = c2; }
        fin[(w * 64 + lane) * 2] = er; fin[(w * 64 + lane) * 2 + 1] = ei;
    }
    __syncthreads();
    {
        float cr = 0.f, ci = 0.f;
        for (int ww = 0; ww < w; ++ww) {
            const float fr_ = fin[(ww * 64 + lane) * 2], fi_ = fin[(ww * 64 + lane) * 2 + 1];
            const float a = l256r * cr - l256i * ci + fr_, c2 = l256r * ci + l256i * cr + fi_;
            cr = a; ci = c2;
        }
#pragma unroll
        for (int sc = 0; sc < 16; ++sc) {
            *(LAS unsigned*)(SinL + sc * 272 + 4 * lane) = cvt_pk_bf16(cr, ci);
            const float a = l16r * cr - l16i * ci + sl[sc].x, c2 = l16r * ci + l16i * cr + sl[sc].y; cr = a; ci = c2;
        }
        if (w == 7) {
            OUTP()[O_PRE + ((size_t)(l * 8 + b) * 32 + g) * 64 + lane] = cr;
            OUTP()[O_PIM + ((size_t)(l * 8 + b) * 32 + g) * 64 + lane] = ci;
        }
    }
    __syncthreads();
    {
        float l8r = me.lr, l8i = me.li;
#pragma unroll
        for (int i2 = 0; i2 < 3; ++i2) { const float a = l8r * l8r - l8i * l8i, c2 = 2.f * l8r * l8i; l8r = a; l8i = c2; }
        float qr = 1.f, qi = 0.f;
        for (int i2 = 0; i2 < w; ++i2) { const float a = qr * me.lr - qi * me.li, c2 = qr * me.li + qi * me.lr; qr = a; qi = c2; }
        const int ntau = (w == 0) ? 3 : 2;
        for (int it = 0; it < ntau; ++it) {
            const int tau = w + 8 * it;
#pragma unroll
            for (int h = 0; h < 16; ++h) {
                const float zr = ccr[h] * qr - cci[h] * qi, zi = ccr[h] * qi + cci[h] * qr;
                *(LAS unsigned*)(RA + (tau * 16 + h) * SSM_CPS + 4 * lane) = cvt_pk_bf16(zr, -zi);
            }
            const float a = qr * l8r - qi * l8i, c2 = qr * l8i + qi * l8r; qr = a; qi = c2;
        }
        if (tid < 128) *(LAS unsigned*)(KmL + 16 * 512 + 4 * tid) = 0u;
    }
    __syncthreads();
    {
        bf16x8 bb[4];
#pragma unroll
        for (int s4 = 0; s4 < 4; ++s4) bb[s4] = *(const LAS bf16x8*)(BbT + fr * 272 + (32 * s4 + 8 * fq) * 2);
#pragma unroll
        for (int tt2 = 0; tt2 < 2; ++tt2) {
            const int tau = 2 * w + tt2;
            f32x4 a = {0.f, 0.f, 0.f, 0.f};
#pragma unroll
            for (int s4 = 0; s4 < 4; ++s4) {
                const bf16x8 cf = *(const LAS bf16x8*)(RA + (tau * 16 + fr) * SSM_CPS + (32 * s4 + 8 * fq) * 2);
                a = __builtin_amdgcn_mfma_f32_16x16x32_bf16(cf, bb[s4], a, 0, 0, 0);
            }
#pragma unroll
            for (int r = 0; r < 4; ++r) *(LAS bf16_t*)(KmL + ((tau * 16 + 4 * fq + r) * 16 + fr) * 2) = f2bf_sw(a[r]);
        }
    }
    __syncthreads();
    {
        bf16x8 sf[4];
#pragma unroll
        for (int s4 = 0; s4 < 4; ++s4) sf[s4] = *(const LAS bf16x8*)(SinL + fr * 272 + (32 * s4 + 8 * fq) * 2);
#pragma unroll
        for (int half = 0; half < 2; ++half) {
            f32x4 acc[8];
            u32x2 uu[8];
#pragma unroll
            for (int jj = 0; jj < 8; ++jj) {
                const int j = half * 8 + jj;
                uu[jj] = *(const u32x2*)(Z + zoff(zrow0 + 16 * fr + j, C_UA + g * 16 + 4 * fq));
                f32x4 a = {0.f, 0.f, 0.f, 0.f};
#pragma unroll
                for (int s4 = 0; s4 < 4; ++s4) {
                    const bf16x8 cf = *(const LAS bf16x8*)(RA + ((j + 1) * 16 + fr) * SSM_CPS + (32 * s4 + 8 * fq) * 2);
                    a = __builtin_amdgcn_mfma_f32_16x16x32_bf16(cf, sf[s4], a, 0, 0, 0);
                }
#pragma unroll
                for (int s8 = 0; s8 < 8; ++s8) {
                    if (2 * s8 <= j) {
                        int tau = j - 2 * s8 - (fq >> 1); tau = tau < 0 ? 16 : tau;
                        const bf16x8 tf = *(const LAS bf16x8*)(KmL + (tau * 16 + fr) * 32 + 16 * (fq & 1));
                        a = __builtin_amdgcn_mfma_f32_16x16x32_bf16(tf, uf[s8], a, 0, 0, 0);
                    }
                }
                acc[jj] = a;
            }
#pragma unroll
            for (int jj = 0; jj < 8; ++jj) {
                const int j = half * 8 + jj;
                f32x4 o;
                o[0] = gelu_tanh(acc[jj][0] + dv[0] * bflo(uu[jj].x)); o[1] = gelu_tanh(acc[jj][1] + dv[1] * bfhi(uu[jj].x));
                o[2] = gelu_tanh(acc[jj][2] + dv[2] * bflo(uu[jj].y)); o[3] = gelu_tanh(acc[jj][3] + dv[3] * bfhi(uu[jj].y));
                *(u32x2*)(Ya + (zrow0 + 16 * fr + j) * 512 + g * 16 + 4 * fq) = pack4(o);
            }
        }
    }
    __syncthreads();
}

__device__ __forceinline__ void ssm_sample_task(const Params& p, int l, int item) {
    const int tid = opaque_tid(), w = tid >> 6, lane = tid & 63;
    const bf16_t* Z = (const bf16_t*)(WS(p) + W_Z);
    bf16_t* Ya = (bf16_t*)(WS(p) + W_YA);
#pragma unroll 1
    for (int q = 0; q < 2; ++q) {
        const int pair = item * 16 + w * 2 + q, bs = pair >> 5, g = pair & 31;
        const size_t row = (size_t)TP + bs;
        const size_t sidx = ((size_t)(l * 128 + bs) * 32 + g) * 64 + lane;
        const u32x4 u0 = *(const u32x4*)(Z + zoff(row, C_UA + g * 16)), u1 = *(const u32x4*)(Z + zoff(row, C_UA + g * 16 + 8));
        const float* brp = IN(I_BRE) + ((size_t)(l * 32 + g) * 64 + lane) * 16;
        const float* bip = IN(I_BIM) + ((size_t)(l * 32 + g) * 64 + lane) * 16;
        f32x4 vbr[4], vbi[4], vd[4];
#pragma unroll
        for (int k = 0; k < 4; ++k) { vbr[k] = *(const f32x4*)(brp + 4 * k); vbi[k] = *(const f32x4*)(bip + 4 * k); vd[k] = *(const f32x4*)(IN(I_D) + l * 512 + g * 16 + 4 * k); }
        const float* crp = IN(I_CRE) + ((size_t)(l * 32 + g) * 16) * 64 + lane;
        const float* cip = IN(I_CIM) + ((size_t)(l * 32 + g) * 16) * 64 + lane;
        float ccr[16], cci[16];
#pragma unroll
        for (int h = 0; h < 16; ++h) { ccr[h] = crp[h * 64]; cci[h] = cip[h * 64]; }
        const float s0r = IN(I_SRE)[sidx], s0i = IN(I_SIM)[sidx];
        const SsmCoef me = ssm_coef(p, l, g, lane);
        float u[16];
        { const f32x4 a = unlo(u0), b2 = unhi(u0), c = unlo(u1), d2 = unhi(u1);
#pragma unroll
          for (int e = 0; e < 4; ++e) { u[e] = a[e]; u[4 + e] = b2[e]; u[8 + e] = c[e]; u[12 + e] = d2[e]; } }
        float bur = 0.f, bui = 0.f;
#pragma unroll
        for (int h = 0; h < 16; ++h) {
            const float vr = vbr[h >> 2][h & 3], vi = vbi[h >> 2][h & 3];
            bur += (me.cr * vr - me.ci * vi) * u[h]; bui += (me.cr * vi + me.ci * vr) * u[h];
        }
        const float sr = me.lr * s0r - me.li * s0i + bur, si = me.lr * s0i + me.li * s0r + bui;
        float myy = 0.f;
#pragma unroll
        for (int h = 0; h < 16; ++h) {
            float y = wave_sum(sr * ccr[h] - si * cci[h]);
            y += vd[h >> 2][h & 3] * u[h];
            if (lane == h) myy = y;
        }
        OUTP()[O_SRE + sidx] = sr; OUTP()[O_SIM + sidx] = si;
        if (lane < 16) Ya[row * 512 + g * 16 + lane] = f2bf(gelu_tanh(myy));
    }
}

__device__ __forceinline__ void conv_ln_rows(const Params& p, int l, const float* co, size_t row, int lane, int w, u32x4 zb) {
    const bf16_t* Z = (const bf16_t*)(WS(p) + W_Z);
    bf16_t* Cb = (bf16_t*)(WS(p) + W_ABR);
    const f32x4 a0 = *(const f32x4*)(co + w * 512 + lane * 8), a1 = *(const f32x4*)(co + w * 512 + lane * 8 + 4);
    float s = (a0[0] + a0[1]) + (a0[2] + a0[3]) + (a1[0] + a1[1]) + (a1[2] + a1[3]);
    s = wave_sum(s);
    const float mu = s * (1.0f / 512.0f);
    const f32x4 d0 = a0 - mu, d1 = a1 - mu;
    float q = d0[0] * d0[0] + d0[1] * d0[1] + d0[2] * d0[2] + d0[3] * d0[3] + d1[0] * d1[0] + d1[1] * d1[1] + d1[2] * d1[2] + d1[3] * d1[3];
    q = wave_sum(q);
    const float rstd = rsqrtf(q * (1.0f / 512.0f) + EPS);
    const float* lg = IN(I_LNG) + l * 512 + lane * 8; const float* lb = IN(I_LNB) + l * 512 + lane * 8;
    const f32x4 g0 = *(const f32x4*)lg, g1 = *(const f32x4*)(lg + 4), b0 = *(const f32x4*)lb, b1 = *(const f32x4*)(lb + 4);
    f32x4 o0 = d0 * rstd * g0 + b0, o1 = d1 * rstd * g1 + b1;
    u32x4 wv;
    wv.x = cvt_pk_bf16(siluf_(o0[0]) * bflo(zb.x), siluf_(o0[1]) * bfhi(zb.x));
    wv.y = cvt_pk_bf16(siluf_(o0[2]) * bflo(zb.y), siluf_(o0[3]) * bfhi(zb.y));
    wv.z = cvt_pk_bf16(siluf_(o1[0]) * bflo(zb.z), siluf_(o1[1]) * bfhi(zb.z));
    wv.w = cvt_pk_bf16(siluf_(o1[2]) * bflo(zb.w), siluf_(o1[3]) * bfhi(zb.w));
    *(u32x4*)(Cb + row * 1536 + lane * 8) = wv;
}

__device__ __forceinline__ void conv_prompt_task(const Params& p, int l, int b, int tile) {
    const int c = opaque_tid(), w = c >> 6, lane = c & 63;
    bf16_t* vt = (bf16_t*)smem;
    float* co = (float*)(smem + 94 * 512 * 2);
    const bf16_t* Z = (const bf16_t*)(WS(p) + W_Z);
    const int t0 = tile * 64;
    float wk[31];
#pragma unroll
    for (int k = 0; k < 31; ++k) wk[k] = IN(I_CONVW)[(size_t)(l * 31 + k) * 512 + c];
    const float bias = IN(I_CONVB)[l * 512 + c];
    u32x4 zbv[8];
#pragma unroll
    for (int i = 0; i < 8; ++i) zbv[i] = *(const u32x4*)(Z + zoff((size_t)b * SEQ + t0 + (i >> 1) * 16 + (i & 1) * 8 + w, C_ZB + lane * 8));
    {
        u32x4 av[12];
#pragma unroll
        for (int i = 0; i < 12; ++i) {
            const int rr = w + 8 * i, t = t0 - 30 + rr;
            const bool ok = (t >= 0) && (rr < 94);
            const size_t row = (size_t)b * SEQ + (ok ? t : 0);
            av[i] = *(const u32x4*)(Z + zoff(row, C_UB + lane * 8));
        }
#pragma unroll
        for (int i = 0; i < 12; ++i) {
            const int rr = w + 8 * i, t = t0 - 30 + rr;
            if (rr < 94) {
                u32x4 o = {0u, 0u, 0u, 0u};
                if (t >= 0) o = av[i];
                *(u32x4*)(vt + rr * 512 + lane * 8) = o;
            }
        }
    }
    __syncthreads();
    if (tile == 31) {
        for (int j = 0; j < 30; ++j) OUTP()[O_PCONV + ((size_t)(l * 8 + b) * 30 + j) * 512 + c] = bf2f(vt[(64 + j) * 512 + c]);
    }
#pragma unroll 1
    for (int sb = 0; sb < 4; ++sb) {
        float acc[16];
#pragma unroll
        for (int o = 0; o < 16; ++o) acc[o] = bias;
#pragma unroll
        for (int j = 0; j < 46; ++j) {
            const float v = bf2f(vt[(sb * 16 + j) * 512 + c]);
#pragma unroll
            for (int o = 0; o < 16; ++o) { const int k = j - o; if (k >= 0 && k < 31) acc[o] += wk[k] * v; }
        }
#pragma unroll
        for (int o = 0; o < 16; ++o) co[o * 512 + c] = acc[o];
        __syncthreads();
        { u32x4 z0 = zbv[0], z1 = zbv[1];
          if (sb == 1) { z0 = zbv[2]; z1 = zbv[3]; } else if (sb == 2) { z0 = zbv[4]; z1 = zbv[5]; } else if (sb == 3) { z0 = zbv[6]; z1 = zbv[7]; }
          conv_ln_rows(p, l, co, (size_t)b * SEQ + t0 + sb * 16 + w, lane, w, z0);
          conv_ln_rows(p, l, co, (size_t)b * SEQ + t0 + sb * 16 + 8 + w, lane, 8 + w, z1); }
        __syncthreads();
    }
}

__device__ __forceinline__ void conv_sample_task(const Params& p, int l, int bs) {
    const int c = opaque_tid(), w = c >> 6, lane = c & 63;
    float* co = (float*)smem;
    const bf16_t* Z = (const bf16_t*)(WS(p) + W_Z);
    const float* __restrict__ st = IN(I_SCONV) + (size_t)(l * 128 + bs) * 30 * 512 + c;
    float* __restrict__ nb = OUTP() + O_SCONV + (size_t)(l * 128 + bs) * 30 * 512 + c;
    const float* __restrict__ cw = IN(I_CONVW) + (size_t)l * 31 * 512 + c;
    float f[30];
#pragma unroll
    for (int k = 0; k < 30; ++k) f[k] = st[(size_t)k * 512];
    const size_t row = (size_t)TP + bs;
    const float v = bf2f(Z[zoff(row, C_UB + c)]);
    float acc = IN(I_CONVB)[l * 512 + c];
#pragma unroll
    for (int k = 0; k < 30; ++k) acc += cw[(size_t)k * 512] * f[k];
    acc += cw[(size_t)30 * 512] * v;
#pragma unroll
    for (int k = 1; k < 30; ++k) nb[(size_t)(k - 1) * 512] = f[k];
    nb[(size_t)29 * 512] = v;
    co[c] = acc;
    __syncthreads();
    if (w == 0) conv_ln_rows(p, l, co, row, lane, 0, *(const u32x4*)(Z + zoff(row, C_ZB + lane * 8)));
    __syncthreads();
}

constexpr int KS_STRIDE = 272, VS_STRIDE = 528, KS_BYTES = 256 * KS_STRIDE;
__device__ __forceinline__ void attn_prompt_task(const Params& p, int l, int item) {
    const int tid = opaque_tid(), w = tid >> 6, lane = tid & 63, fr = lane & 15, fq = lane >> 4;
    const int hp = item & 1, tile = (item >> 1) & 15, b = item >> 5;
    const bf16_t* Z = (const bf16_t*)(WS(p) + W_Z);
    const bf16_t* Kb = (const bf16_t*)(WS(p) + W_KB) + ((size_t)l * 2048 + b * 256) * 512;
    const bf16_t* Vt = (const bf16_t*)(WS(p) + W_VT) + ((size_t)l * 2048 * 512) + (size_t)b * 4 * 128 * 256;
    bf16_t* Ob = (bf16_t*)(WS(p) + W_ABR) + 512;
    LAS unsigned char* Ks = (LAS unsigned char*)smem;
    LAS unsigned char* Vs = (LAS unsigned char*)smem + KS_BYTES;
    const size_t row = (size_t)b * SEQ + tile * 128 + w * 16 + fr;
    const float sc = 1.4426950408889634f * 0.08838834764831845f;
#pragma unroll 1
    for (int hh = 0; hh < 2; ++hh) {
        const int head = hp * 2 + hh;
        __syncthreads();
        bf16x8 qf[4];
        u32x2 zxv[8];
        {
            const int c = tid & 15, r0 = tid >> 4;
            const int c2 = tid & 31, q0 = tid >> 5;
            u32x4 kt[8], vtl[8];
#pragma unroll
            for (int i = 0; i < 8; ++i) kt[i] = *(const u32x4*)(Kb + (size_t)(r0 + 32 * i) * 512 + head * 128 + c * 8);
#pragma unroll
            for (int i = 0; i < 8; ++i) vtl[i] = *(const u32x4*)(Vt + ((size_t)(head * 128 + q0 + 16 * i)) * 256 + c2 * 8);
#pragma unroll
            for (int ks = 0; ks < 4; ++ks) qf[ks] = *(const bf16x8*)(Z + zoff(row, C_Q + head * 128 + ks * 32 + 8 * fq));
#pragma unroll
            for (int e = 0; e < 8; ++e) zxv[e] = *(const u32x2*)(Z + zoff(row, C_ZX + head * 128 + 16 * e + 4 * fq));
#pragma unroll
            for (int i = 0; i < 8; ++i) *(LAS u32x4*)(Ks + (r0 + 32 * i) * KS_STRIDE + c * 16) = kt[i];
#pragma unroll
            for (int i = 0; i < 8; ++i) *(LAS u32x4*)(Vs + (q0 + 16 * i) * VS_STRIDE + c2 * 16) = vtl[i];
        }
        __syncthreads();
        f32x4 s[16];
        __builtin_amdgcn_s_setprio(1);
#pragma unroll
        for (int mt = 0; mt < 16; ++mt) {
            f32x4 a = {0.f, 0.f, 0.f, 0.f};
#pragma unroll
            for (int ks = 0; ks < 4; ++ks) {
                const bf16x8 kf = *(const LAS bf16x8*)(Ks + (mt * 16 + fr) * KS_STRIDE + ks * 64 + fq * 16);
                a = __builtin_amdgcn_mfma_f32_16x16x32_bf16(kf, qf[ks], a, 0, 0, 0);
            }
            s[mt] = a;
        }
        __builtin_amdgcn_s_setprio(0);
        float mx = -3.0e38f;
#pragma unroll
        for (int mt = 0; mt < 16; ++mt) mx = fmaxf(mx, fmaxf(fmaxf(s[mt][0], s[mt][1]), fmaxf(s[mt][2], s[mt][3])));
        mx = fmaxf(mx, __shfl_xor(mx, 16)); mx = fmaxf(mx, __shfl_xor(mx, 32));
        float sum = 0.f;
#pragma unroll
        for (int mt = 0; mt < 16; ++mt)
#pragma unroll
            for (int r = 0; r < 4; ++r) { const float e = __builtin_amdgcn_exp2f((s[mt][r] - mx) * sc); s[mt][r] = e; sum += e; }
        sum += __shfl_xor(sum, 16); sum += __shfl_xor(sum, 32);
        const float inv = 1.0f / sum;
        f32x4 o[8];
#pragma unroll
        for (int e = 0; e < 8; ++e) o[e] = (f32x4){0.f, 0.f, 0.f, 0.f};
        __builtin_amdgcn_s_setprio(1);
#pragma unroll
        for (int ks = 0; ks < 8; ++ks) {
            union { bf16x8 v; unsigned u[4]; } pf;
            pf.u[0] = cvt_pk_bf16(s[2 * ks][0], s[2 * ks][1]); pf.u[1] = cvt_pk_bf16(s[2 * ks][2], s[2 * ks][3]);
            pf.u[2] = cvt_pk_bf16(s[2 * ks + 1][0], s[2 * ks + 1][1]); pf.u[3] = cvt_pk_bf16(s[2 * ks + 1][2], s[2 * ks + 1][3]);
#pragma unroll
            for (int e = 0; e < 8; ++e) {
                LAS unsigned char* vp = Vs + (16 * e + fr) * VS_STRIDE + (32 * ks + 4 * fq) * 2;
                union { bf16x8 v; u32x2 h[2]; } vf;
                vf.h[0] = *(const LAS u32x2*)vp; vf.h[1] = *(const LAS u32x2*)(vp + 32);
                o[e] = __builtin_amdgcn_mfma_f32_16x16x32_bf16(vf.v, pf.v, o[e], 0, 0, 0);
            }
        }
        __builtin_amdgcn_s_setprio(0);
#pragma unroll
        for (int e = 0; e < 8; ++e) {
            const int col = head * 128 + 16 * e + 4 * fq;
            const u32x2 zx = zxv[e];
            f32x4 r;
            r[0] = o[e][0] * inv * bflo(zx.x); r[1] = o[e][1] * inv * bfhi(zx.x); r[2] = o[e][2] * inv * bflo(zx.y); r[3] = o[e][3] * inv * bfhi(zx.y);
            *(u32x2*)(Ob + row * 1536 + col) = pack4(r);
        }
    }
    __syncthreads();
}

__device__ __forceinline__ void attn_sample_task(const Params& p, int l, int item) {
    const int tid = opaque_tid(), w = tid >> 6, lane = tid & 63;
    const int bs = item >> 1, h0 = (item & 1) * 2;
    const bf16_t* Z = (const bf16_t*)(WS(p) + W_Z);
    bf16_t* Ob = (bf16_t*)(WS(p) + W_ABR) + 512;
    float* scs = (float*)smem;
    float* red = (float*)(smem + 2048);
    const size_t row = (size_t)TP + bs;
    const float* Kc = IN(I_CK) + ((size_t)(l * 128 + bs) * 256) * 512 + h0 * 128;
    const float* Vc = IN(I_CV) + ((size_t)(l * 128 + bs) * 256) * 512 + h0 * 128;
    const float sc = 1.4426950408889634f * 0.08838834764831845f;
    const bf16_t zxg = Z[zoff(row, C_ZX + h0 * 128 + (tid & 255))];
    {
        const int hh = lane >> 5, d4 = lane & 31;
        const u32x2 qq = *(const u32x2*)(Z + zoff(row, C_Q + (h0 + hh) * 128 + d4 * 4));
        const float q0 = bflo(qq.x), q1 = bfhi(qq.x), q2 = bflo(qq.y), q3 = bfhi(qq.y);
        f32x4 kv[32];
#pragma unroll
        for (int i = 0; i < 32; ++i) kv[i] = __builtin_nontemporal_load((const f32x4*)(Kc + (size_t)(w * 32 + i) * 512 + lane * 4));
#pragma unroll
        for (int i = 0; i < 32; ++i) {
            float d = kv[i][0] * q0 + kv[i][1] * q1 + kv[i][2] * q2 + kv[i][3] * q3;
            d += __shfl_xor(d, 16); d += __shfl_xor(d, 8); d += __shfl_xor(d, 4); d += __shfl_xor(d, 2); d += __shfl_xor(d, 1);
            if (d4 == 0) scs[hh * 256 + w * 32 + i] = d;
        }
    }
    __syncthreads();
    f32x4 vv[32];
#pragma unroll
    for (int i = 0; i < 32; ++i) vv[i] = __builtin_nontemporal_load((const f32x4*)(Vc + (size_t)(w * 32 + i) * 512 + lane * 4));
    if (w < 2) {
        float v[4]; float mx = -3.0e38f;
#pragma unroll
        for (int i = 0; i < 4; ++i) { v[i] = scs[w * 256 + lane + 64 * i]; mx = fmaxf(mx, v[i]); }
        mx = wave_max(mx);
        float sum = 0.f;
#pragma unroll
        for (int i = 0; i < 4; ++i) { v[i] = exp2f((v[i] - mx) * sc); sum += v[i]; }
        sum = wave_sum(sum);
        const float inv = 1.0f / sum;
#pragma unroll
        for (int i = 0; i < 4; ++i) scs[w * 256 + lane + 64 * i] = v[i] * inv;
    }
    __syncthreads();
    {
        const int hh = lane >> 5;
        f32x4 acc = {0.f, 0.f, 0.f, 0.f};
#pragma unroll
        for (int i = 0; i < 32; ++i) acc += vv[i] * scs[hh * 256 + w * 32 + i];
        *(f32x4*)(red + w * 256 + lane * 4) = acc;
    }
    __syncthreads();
    if (tid < 256) {
        float o = 0.f;
#pragma unroll
        for (int ww = 0; ww < 8; ++ww) o += red[ww * 256 + tid];
        const int col = h0 * 128 + tid;
        o *= bf2f(zxg);
        Ob[row * 1536 + col] = f2bf(o);
    }
    __syncthreads();
}

__device__ __forceinline__ void phase_mid(const Params& p, int l) {
    const int G = gridDim.x, bx = blockIdx.x;
    const bool early = ((bx >> 3) & 1) != 0;
    if (early) {
#pragma unroll 1
        for (int it = bx; it < 256; it += G) attn_sample_task(p, l, it);
    }
#pragma unroll 1
    for (int it = bx; it < 256; it += G) ssm_prompt_task(p, l, it >> 5, it & 31);
#pragma unroll 1
    for (int it = bx; it < 256; it += G) attn_prompt_task(p, l, it);
#pragma unroll 1
    for (int it = bx; it < 256; it += G) conv_prompt_task(p, l, it >> 5, it & 31);
#pragma unroll 1
    for (int it = bx; it < 256; it += G) ssm_sample_task(p, l, it);
#pragma unroll 1
    for (int it = bx; it < 128; it += G) conv_sample_task(p, l, it);
    if (!early) {
#pragma unroll 1
        for (int it = bx; it < 256; it += G) attn_sample_task(p, l, it);
    }
}

__global__ void __launch_bounds__(NTHREADS) fwd_megakernel(Params p) {
    cg::grid_group grid = cg::this_grid();
    if (WS(p) == nullptr) grid.sync();
    volatile LAS unsigned* st = (volatile LAS unsigned*)((LAS unsigned char*)smem + LDS_ST_OFF);
    if (threadIdx.x == 0) { st[0] = 0u; st[1] = 0u; st[2] = 0u; st[3] = 0u; }
    __syncthreads();
    const XcdBarrier gb = xcd_barrier_post((unsigned*)(WS(p) + W_BAR), st);
    phase_prep(p);
    xcd_barrier(gb);
    phase_inproj(p, 0);
    xcd_barrier(gb);
    phase_mid(p, 0);
    convert_weights(p, 1, 0, gridDim.x);
    xcd_barrier(gb);
    phase_glu_br(p, 0);
    xcd_barrier(gb);
    phase_out(p, 0);
    xcd_barrier(gb);
    phase_norm(p, 1);
    xcd_barrier(gb);
    phase_inproj(p, 1);
    xcd_barrier(gb);
    phase_mid(p, 1);
    xcd_barrier(gb);
    phase_glu_br(p, 1);
    xcd_barrier(gb);
    phase_out(p, 1);
    xcd_barrier(gb);
    phase_final(p);
}

extern "C" void kernel_launch(void* const* d_in, const int* in_sizes, int n_in, void* d_out, int out_size, void* d_ws, size_t ws_size, hipStream_t stream) {
    static int grid_blocks = 0;
    if (!grid_blocks) {
        int dev = 0, cus = 0, per_cu = 0;
        (void)hipGetDevice(&dev);
        (void)hipDeviceGetAttribute(&cus, hipDeviceAttributeMultiprocessorCount, dev);
        (void)hipFuncSetAttribute((const void*)fwd_megakernel, hipFuncAttributeMaxDynamicSharedMemorySize, LDS_BYTES);
        (void)hipOccupancyMaxActiveBlocksPerMultiprocessor(&per_cu, (const void*)fwd_megakernel, NTHREADS, LDS_BYTES);
        if (per_cu < 1) per_cu = 1;
        if (per_cu > 1) per_cu = 1;
        grid_blocks = cus * per_cu;
        if (ws_size < W_END) fprintf(stderr, "kernel_launch: workspace too small: %zu < %zu\n", ws_size, (size_t)W_END);
    }
    Params p{};
    for (int i = 0; i < 32; ++i) p.in[i] = (const float*)d_in[i];
    p.out = (float*)d_out; p.ws = (unsigned char*)d_ws;
    void* args[] = {&p};
    (void)hipMemsetAsync((unsigned char*)d_ws + W_BAR, 0, 16384, stream);
    hipError_t e = hipLaunchCooperativeKernel((const void*)fwd_megakernel, dim3(grid_blocks), dim3(NTHREADS), args, LDS_BYTES, stream);
    if (e != hipSuccess) fprintf(stderr, "cooperative launch failed: %s (grid %d)\n", hipGetErrorString(e), grid_blocks);
}
```

```cpp
#include <hip/hip_runtime.h>
#include <hip/hip_cooperative_groups.h>
#include <cstdio>
namespace cg = cooperative_groups;

typedef unsigned short bf16_t;
typedef short bf16x8 __attribute__((ext_vector_type(8)));
typedef float f32x4 __attribute__((ext_vector_type(4)));
typedef float f32x2 __attribute__((ext_vector_type(2)));
typedef unsigned u32x2 __attribute__((ext_vector_type(2)));
typedef unsigned u32x4 __attribute__((ext_vector_type(4)));

constexpr int DM = 1024, TP = 16384, TS = 128, TT = TP + TS, MP = 16640, SEQ = 2048, NB = 8;
constexpr int ZW = 6656;
constexpr int C_UA = 0, C_ZA = 512, C_UB = 1024, C_UG = 1536, C_ZB = 2048, C_Q = 2560, C_ZX = 3072, C_GA = 3584, C_GB = 4608, C_GX = 5632;
constexpr float EPS = 1e-6f;
constexpr int NTHREADS = 512;
constexpr int LDS_BYTES = 147456;
constexpr int LDS_ST_OFF = LDS_BYTES - 16;

enum { I_XP = 0, I_XS, I_MEM, I_SRE, I_SIM, I_SCONV, I_CK, I_CV, I_NORMG, I_WIN, I_ARE, I_AIM, I_LOGDT, I_BRE, I_BIM, I_CRE, I_CIM, I_D,
       I_WGLU, I_BGLU, I_WBRS, I_CONVW, I_CONVB, I_LNG, I_LNB, I_WBRC, I_MEMG, I_WK, I_WV, I_WBRX, I_WOUT, I_FING };

constexpr size_t O_YP = 0;
constexpr size_t O_YS = O_YP + (size_t)TP * DM;
constexpr size_t O_PRE = O_YS + (size_t)TS * DM;
constexpr size_t O_PIM = O_PRE + 2 * 8 * 32 * 64;
constexpr size_t O_PCONV = O_PIM + 2 * 8 * 32 * 64;
constexpr size_t O_PK = O_PCONV + 2 * 8 * 30 * 512;
constexpr size_t O_PV = O_PK + (size_t)2 * 8 * 256 * 512;
constexpr size_t O_SRE = O_PV + (size_t)2 * 8 * 256 * 512;
constexpr size_t O_SIM = O_SRE + (size_t)2 * 128 * 32 * 64;
constexpr size_t O_SCONV = O_SIM + (size_t)2 * 128 * 32 * 64;

constexpr size_t W_Z = 0;
constexpr size_t W_H = W_Z + (size_t)MP * ZW * 2;
constexpr size_t W_XN = W_H + (size_t)MP * DM * 2;
constexpr size_t W_YA = W_XN + (size_t)MP * DM * 4;
constexpr size_t W_ABR = W_YA + (size_t)MP * 512 * 2;
constexpr size_t W_WT = W_ABR + (size_t)MP * 1536 * 2;
constexpr size_t WT_IN = 0, WT_GLU = WT_IN + (size_t)ZW * 1024, WT_BR = WT_GLU + 512 * 512,
                 WT_K = WT_BR + 1024 * 1536, WT_V = WT_K + 512 * 1024, WT_OUT = WT_V + 512 * 1024, WT_LAYER = WT_OUT + 1024 * 1024;
constexpr size_t W_HM = W_WT + 2 * WT_LAYER * 2;
constexpr size_t W_KB = W_HM + (size_t)2 * 2048 * 1024 * 2;
constexpr size_t W_VT = W_KB + (size_t)2 * 2048 * 512 * 2;
constexpr size_t W_BAR = W_VT + (size_t)2 * 2048 * 512 * 2;
constexpr size_t W_CNT = W_BAR + 14336;
constexpr size_t W_END = W_BAR + 16384;

__device__ __forceinline__ size_t zoff(size_t row, int col) { return ((size_t)(col >> 8) * MP + row) * 256 + (size_t)(col & 255); }
struct Params {
    const float* in[32];
    float* out;
    unsigned char* ws;
};

extern __shared__ __attribute__((aligned(16))) unsigned char smem[];

__device__ __forceinline__ unsigned cvt_pk_bf16(float lo, float hi) { unsigned r; asm("v_cvt_pk_bf16_f32 %0, %1, %2" : "=v"(r) : "v"(lo), "v"(hi)); return r; }
__device__ __forceinline__ bf16_t f2bf(float f) { return (bf16_t)(cvt_pk_bf16(f, 0.f) & 0xffffu); }
__device__ __forceinline__ bf16_t f2bf_sw(float f) { unsigned u = __float_as_uint(f); u += 0x7fffu + ((u >> 16) & 1u); return (bf16_t)(u >> 16); }
__device__ __forceinline__ float bf2f(bf16_t h) { return __uint_as_float((unsigned)h << 16); }
__device__ __forceinline__ float bflo(unsigned w) { return __uint_as_float(w << 16); }
__device__ __forceinline__ float bfhi(unsigned w) { return __uint_as_float(w & 0xffff0000u); }
__device__ __forceinline__ float sigmoidf_(float x) { return __builtin_amdgcn_rcpf(1.0f + __expf(-x)); }
__device__ __forceinline__ float siluf_(float x) { return x * sigmoidf_(x); }
__device__ __forceinline__ float gelu_tanh(float x) {
    const float u = 0.7978845608028654f * (x + 0.044715f * x * x * x);
    return x * sigmoidf_(2.0f * u);
}
typedef __attribute__((address_space(4))) const unsigned char* karg_t;
__device__ __forceinline__ karg_t kargs() { karg_t k = (karg_t)__builtin_amdgcn_kernarg_segment_ptr(); asm volatile("" : "+s"(k)); return k; }
__device__ __forceinline__ const float* IN(int i) { return *(const float* __attribute__((address_space(4))) const*)(kargs() + 8 * i); }
__device__ __forceinline__ float* OUTP() { return *(float* __attribute__((address_space(4))) const*)(kargs() + 256); }
struct Params;
__device__ __forceinline__ unsigned char* WS(const Params&) { return *(unsigned char* __attribute__((address_space(4))) const*)(kargs() + 264); }
__device__ __forceinline__ int opaque_tid() { int t = threadIdx.x; asm volatile("" : "+v"(t)); return t; }
__device__ __forceinline__ float wave_sum(float v) {
#pragma unroll
    for (int o = 32; o > 0; o >>= 1) v += __shfl_xor(v, o);
    return v;
}
__device__ __forceinline__ float wave_max(float v) {
#pragma unroll
    for (int o = 32; o > 0; o >>= 1) v = fmaxf(v, __shfl_xor(v, o));
    return v;
}

#define LAS __attribute__((address_space(3)))
#define XB_TMO      128
#define XB_XCNT(j)  (256  + 64 * (j))
#define XB_XSUB(j)  (1280 + 64 * (j))
#define XB_XGEN(j)  (2304 + 64 * (j))
#define XB_TOP      3328
#define XB_TOPGEN   3392
#define XCD_BAR_WORDS 3456
#define XB_SPIN_CAP (1u << 18)
__device__ __forceinline__ unsigned xb_ld(unsigned* p)              { return __hip_atomic_load(p, __ATOMIC_RELAXED, __HIP_MEMORY_SCOPE_AGENT); }
__device__ __forceinline__ unsigned xb_add(unsigned* p, unsigned v) { return __hip_atomic_fetch_add(p, v, __ATOMIC_RELAXED, __HIP_MEMORY_SCOPE_AGENT); }
__device__ __forceinline__ unsigned xb_xcc_id() { return (unsigned)__builtin_amdgcn_s_getreg((3 << 11) | 20) & 0xFu; }
#define XB_SPIN(cond, bar) do { unsigned _sp = 0; while (cond) { __builtin_amdgcn_s_sleep(1); \
    if ((++_sp & 255u) == 0u) { if (xb_ld(&(bar)[XB_TMO])) break; if (_sp > XB_SPIN_CAP) { atomicAdd(&(bar)[XB_TMO], 1u); break; } } } } while (0)
struct XcdBarrier { unsigned* bar; unsigned x; volatile LAS unsigned* st; };
__device__ __forceinline__ XcdBarrier xcd_barrier_post(unsigned* bar, volatile LAS unsigned* st) {
    XcdBarrier b; b.bar = bar; b.x = xb_xcc_id(); b.st = st;
    if (threadIdx.x == 0) (void)xb_add(&bar[XB_XCNT(b.x)], 1u);
    return b;
}
__device__ __forceinline__ void xcd_barrier_complete(unsigned* bar, unsigned x, unsigned& nloc, unsigned& nx) {
    const unsigned G = gridDim.x * gridDim.y * gridDim.z;
    unsigned sum, cnt, mine, sp = 0u;
    for (;;) {
        sum = 0u; cnt = 0u; mine = 0u;
#pragma unroll
        for (unsigned j = 0; j < 16; ++j) { const unsigned c = xb_ld(&bar[XB_XCNT(j)]); sum += c; cnt += (c > 0u) ? 1u : 0u; mine = (j == x) ? c : mine; }
        if (sum == G) break;
        __builtin_amdgcn_s_sleep(1);
        if ((++sp & 255u) == 0u) { if (xb_ld(&bar[XB_TMO])) break; if (sp > XB_SPIN_CAP) { atomicAdd(&bar[XB_TMO], 1u); break; } }
    }
    nloc = mine > 0u ? mine : 1u; nx = cnt > 0u ? cnt : 1u;
}
__device__ __forceinline__ void xcd_barrier(const XcdBarrier& b) {
    asm volatile("s_waitcnt vmcnt(0)" ::: "memory");
    __syncthreads();
    if (threadIdx.x == 0) {
        unsigned* bar = b.bar;
        const unsigned bx_ = (unsigned)__builtin_amdgcn_readfirstlane((int)xb_xcc_id());
        __builtin_amdgcn_s_waitcnt(0);
        unsigned nloc = b.st[0], nx = b.st[1];
        if (nloc == 0u) { xcd_barrier_complete(bar, bx_, nloc, nx); b.st[0] = nloc; b.st[1] = nx; }
        const unsigned old = xb_add(&bar[XB_XSUB(bx_)], 1u);
        const unsigned gen = old / nloc;
        if (old + 1u == (gen + 1u) * nloc) {
            __builtin_amdgcn_fence(__ATOMIC_RELEASE, "agent");
            asm volatile("s_waitcnt vmcnt(0)" ::: "memory");
            const unsigned og = xb_add(&bar[XB_TOP], 1u);
            const unsigned tg = og / nx;
            if (og + 1u == (tg + 1u) * nx) xb_add(&bar[XB_TOPGEN], 1u);
            else XB_SPIN(xb_ld(&bar[XB_TOPGEN]) == tg, bar);
            __builtin_amdgcn_fence(__ATOMIC_ACQUIRE, "agent");
            xb_add(&bar[XB_XGEN(bx_)], 1u);
            asm volatile("s_waitcnt vmcnt(0)" ::: "memory");
        } else {
            XB_SPIN(xb_ld(&bar[XB_XGEN(bx_)]) == gen, bar);
            __builtin_amdgcn_fence(__ATOMIC_ACQUIRE, "agent");
            asm volatile("s_waitcnt vmcnt(0)" ::: "memory");
        }
    }
    __syncthreads();
}

__device__ __forceinline__ void signal_done(unsigned* cnt) {
    asm volatile("s_waitcnt vmcnt(0)" ::: "memory");
    __syncthreads();
    if (threadIdx.x == 0) {
        __builtin_amdgcn_fence(__ATOMIC_RELEASE, "agent");
        asm volatile("s_waitcnt vmcnt(0)" ::: "memory");
        (void)__hip_atomic_fetch_add(cnt, 1u, __ATOMIC_RELAXED, __HIP_MEMORY_SCOPE_AGENT);
    }
}
__device__ __forceinline__ void wait_count(unsigned* cnt, unsigned need) {
    if (threadIdx.x == 0) {
        unsigned sp = 0;
        while (__hip_atomic_load(cnt, __ATOMIC_RELAXED, __HIP_MEMORY_SCOPE_AGENT) < need) { __builtin_amdgcn_s_sleep(2); if (++sp > (1u << 22)) break; }
        __builtin_amdgcn_fence(__ATOMIC_ACQUIRE, "agent");
        asm volatile("s_waitcnt vmcnt(0)" ::: "memory");
    }
    __syncthreads();
}

constexpr int BM = 256, BK = 64, HALF = 128, HTB = HALF * BK * 2;
__device__ __forceinline__ int lds_byte(int r, int c) { const int st = (r >> 4) * 2 + (c >> 5), rr = r & 15, cc = c & 31, ob = rr * 64 + cc * 2; return st * 1024 + (ob ^ (((ob >> 9) & 1) << 5)); }
__device__ __forceinline__ void stage_rc(int b, int& R, int& C) { const int st = b / 1024, sb = b % 1024, swz = sb ^ (((sb >> 9) & 1) << 5); R = (st >> 1) * 16 + swz / 64; C = (st & 1) * 32 + (swz % 64) / 2; }
struct Unit { int pm, pn; };
struct Gemm { const bf16_t* A; const bf16_t* Bt; int K; };
struct Sched {
    int nM, nN, nwg, G, c; int fpm = -1, fpn = 0;
    __device__ __forceinline__ void init(int nM_, int nN_, int G_, int c_) { nM = nM_; nN = nN_; nwg = nM * nN; G = G_; c = c_; fpm = -1; }
    __device__ __forceinline__ void init_single(int pm, int pn) { nM = nN = nwg = 1; G = 1; c = 0; fpm = pm; fpn = pn; }
    __device__ __forceinline__ bool next(int i, Unit& u) const {
        if (fpm >= 0) { if (i > 0) return false; u.pm = fpm; u.pn = fpn; return true; }
        const long L = (long)i * G + c; if (L >= nwg) return false;
        int wgid = (int)L; { const int q = nwg / 8, r = nwg % 8, xcd = wgid % 8, off = wgid / 8; wgid = (xcd < r ? xcd * (q + 1) : r * (q + 1) + (xcd - r) * q) + off; }
        const int nig = 8 * nN, gid = wgid / nig, fm = gid * 8, gsz = (nM - fm) < 8 ? (nM - fm) : 8;
        u.pm = fm + ((wgid % nig) % gsz); u.pn = (wgid % nig) / gsz; return true;
    }
};
template <class Epi>
__device__ __forceinline__ void gemm_phase(const Gemm g, const Sched& S, const Epi& E) {
    LAS unsigned char* lds = (LAS unsigned char*)smem;
    const int tid = opaque_tid(), wid = __builtin_amdgcn_readfirstlane(tid >> 6), lane = tid & 63, wr = wid >> 2, wc = wid & 3, fr = lane & 15, fq = lane >> 4;
    const int K = g.K, nt = K / BK;
    unsigned voff[2];
#pragma unroll
    for (int i = 0; i < 2; ++i) { int R, C; stage_rc(tid * 16 + i * 8192, R, C); voff[i] = (unsigned)(R * K + C) * 2u; }
    const size_t kstep = (size_t)(BK * 2);
    const size_t hstep = (size_t)HALF * K * 2;
    const size_t tstep = 2 * hstep;
    const unsigned ldsw = (unsigned)wid * 1024u;
    const int aoff = lds_byte(wr * 64 + fr, fq * 8), boff = lds_byte(wc * 32 + fr, fq * 8);
#define PG8_SA(b, h) (((b) * 2 + (h)) * HTB)
#define PG8_SB(b, h) ((4 + (b) * 2 + (h)) * HTB)
#define PG8_STAGE(bufoff, gbase) do { _Pragma("unroll") for (int _i = 0; _i < 2; ++_i) \
        __builtin_amdgcn_global_load_lds((const unsigned*)((const char*)(gbase) + voff[_i]), (LAS unsigned*)(lds + (bufoff) + ldsw + _i * 8192), 16, 0, 0); } while (0)
#define PG8_LDA(dst, b, h) do { _Pragma("unroll") for (int m = 0; m < 4; ++m) _Pragma("unroll") for (int k = 0; k < 2; ++k) dst[m][k] = *(const LAS bf16x8*)(lds + PG8_SA(b, h) + aoff + m * 2048 + k * 1024); } while (0)
#define PG8_LDB(dst, b, h) do { _Pragma("unroll") for (int n = 0; n < 2; ++n) _Pragma("unroll") for (int k = 0; k < 2; ++k) dst[n][k] = *(const LAS bf16x8*)(lds + PG8_SB(b, h) + boff + n * 2048 + k * 1024); } while (0)
#define PG8_MMA(ai, bj, At, Bq) do { __builtin_amdgcn_s_setprio(1); _Pragma("unroll") for (int m = 0; m < 4; ++m) _Pragma("unroll") for (int n = 0; n < 2; ++n) _Pragma("unroll") for (int k = 0; k < 2; ++k) \
        acc[ai][bj][m][n] = __builtin_amdgcn_mfma_f32_16x16x32_bf16(Bq[n][k], At[m][k], acc[ai][bj][m][n], 0, 0, 0); __builtin_amdgcn_s_setprio(0); } while (0)
#define PG8_WAIT_V(n) asm volatile("s_waitcnt vmcnt(" #n ")" ::: "memory")
#define PG8_WAIT_L(n) asm volatile("s_waitcnt lgkmcnt(" #n ")" ::: "memory")
#define PG8_BAR __builtin_amdgcn_s_barrier()
#define PG8_SCHED __builtin_amdgcn_sched_barrier(0)
    Unit cur, nxt; int ui = 0;
    if (!S.next(0, cur)) return;
    f32x4 acc[2][2][4][2];
    if constexpr (Epi::INIT) E.init(acc, cur.pm * BM + wr * 64 + fr, cur.pn * BM + wc * 32 + 8 * fq);
    else {
#pragma unroll
        for (int a = 0; a < 2; ++a)
#pragma unroll
            for (int b = 0; b < 2; ++b)
#pragma unroll
                for (int m = 0; m < 4; ++m)
#pragma unroll
                    for (int n = 0; n < 2; ++n) acc[a][b][m][n] = (f32x4){0.f, 0.f, 0.f, 0.f};
    }
    bf16x8 At[4][2], B0[2][2], B1[2][2];
    const char* cA = (const char*)g.A + (size_t)cur.pm * tstep; const char* cB = (const char*)g.Bt + (size_t)cur.pn * tstep;
    PG8_STAGE(PG8_SB(0, 0), cB); PG8_STAGE(PG8_SA(0, 0), cA); PG8_STAGE(PG8_SB(0, 1), cB + hstep); PG8_STAGE(PG8_SA(0, 1), cA + hstep);
    if (wr == 1) PG8_BAR;
    PG8_WAIT_V(4); PG8_BAR;
    PG8_STAGE(PG8_SB(1, 0), cB + kstep); PG8_STAGE(PG8_SA(1, 0), cA + kstep); PG8_STAGE(PG8_SB(1, 1), cB + hstep + kstep);
    PG8_WAIT_V(6); PG8_BAR;
    for (;;) {
        const bool has_next = S.next(ui + 1, nxt);
        const char* nA = has_next ? (const char*)g.A + (size_t)nxt.pm * tstep : cA; const char* nB = has_next ? (const char*)g.Bt + (size_t)nxt.pn * tstep : cB;
        for (int t = 0; t < nt; t += 2) {
            const bool last = (t == nt - 2);
            if constexpr (Epi::WAITK >= 0) { if (t == Epi::WAITK) E.wait_k(cur.pm, wid); }
            if constexpr (Epi::HOOK) { if (t == 8 || t == 16) E.hook(t, acc, cur.pm * BM + wr * 64 + fr, cur.pn * BM + wc * 32 + 8 * fq); }
            const char* a1 = cA + (size_t)(t + 1) * kstep;
            const char* a2 = last ? nA : cA + (size_t)(t + 2) * kstep; const char* b2 = last ? nB : cB + (size_t)(t + 2) * kstep;
            const char* a3 = a2 + kstep; const char* b3 = b2 + kstep;
            PG8_LDB(B0, 0, 0); PG8_SCHED; PG8_LDA(At, 0, 0); PG8_STAGE(PG8_SA(1, 1), a1 + hstep);
            PG8_WAIT_L(8); PG8_BAR; PG8_WAIT_L(0); PG8_MMA(0, 0, At, B0); PG8_BAR; PG8_SCHED;
            PG8_LDB(B1, 0, 1); PG8_STAGE(PG8_SB(0, 0), b2);
            PG8_BAR; PG8_WAIT_L(0); PG8_MMA(0, 1, At, B1); PG8_BAR;
            PG8_LDA(At, 0, 1); PG8_STAGE(PG8_SA(0, 0), a2);
            PG8_BAR; PG8_WAIT_L(0); PG8_MMA(1, 0, At, B0); PG8_BAR; PG8_SCHED;
            PG8_STAGE(PG8_SB(0, 1), b2 + hstep);
            PG8_WAIT_V(6); PG8_BAR; PG8_MMA(1, 1, At, B1); PG8_BAR;
            PG8_LDB(B0, 1, 0); PG8_SCHED; PG8_LDA(At, 1, 0); PG8_STAGE(PG8_SA(0, 1), a2 + hstep);
            PG8_WAIT_L(8); PG8_BAR; PG8_WAIT_L(0); PG8_MMA(0, 0, At, B0); PG8_BAR; PG8_SCHED;
            PG8_LDB(B1, 1, 1); PG8_STAGE(PG8_SB(1, 0), b3);
            PG8_BAR; PG8_WAIT_L(0); PG8_MMA(0, 1, At, B1); PG8_BAR;
            PG8_LDA(At, 1, 1); PG8_STAGE(PG8_SA(1, 0), a3);
            PG8_BAR; PG8_WAIT_L(0); PG8_MMA(1, 0, At, B0); PG8_BAR; PG8_SCHED;
            PG8_STAGE(PG8_SB(1, 1), b3 + hstep);
            PG8_WAIT_V(6); PG8_BAR; PG8_MMA(1, 1, At, B1); PG8_BAR;
        }
        asm volatile("s_nop 15\n\ts_nop 15" ::: "memory");
        E(acc, cur.pm * BM + wr * 64 + fr, cur.pn * BM + wc * 32 + 8 * fq);
        if (!has_next) break;
        cur = nxt; cA = nA; cB = nB; ++ui;
        if constexpr (Epi::INIT) E.init(acc, cur.pm * BM + wr * 64 + fr, cur.pn * BM + wc * 32 + 8 * fq);
        else {
#pragma unroll
            for (int a = 0; a < 2; ++a)
#pragma unroll
                for (int b = 0; b < 2; ++b)
#pragma unroll
                    for (int m = 0; m < 4; ++m)
#pragma unroll
                        for (int n = 0; n < 2; ++n) acc[a][b][m][n] = (f32x4){0.f, 0.f, 0.f, 0.f};
        }
    }
    PG8_WAIT_V(0);
    if (wr == 0) PG8_BAR;
    PG8_BAR;
#undef PG8_SA
#undef PG8_SB
#undef PG8_STAGE
#undef PG8_LDA
#undef PG8_LDB
#undef PG8_MMA
#undef PG8_WAIT_V
#undef PG8_WAIT_L
#undef PG8_BAR
#undef PG8_SCHED
}

__device__ __forceinline__ u32x2 pack4(f32x4 v) { u32x2 w; w.x = cvt_pk_bf16(v[0], v[1]); w.y = cvt_pk_bf16(v[2], v[3]); return w; }

__device__ __forceinline__ int perm_row(int c) { const int x = c & 31; return (c & ~31) + 16 * ((x >> 2) & 1) + 4 * (x >> 3) + (x & 3); }
__device__ __forceinline__ int glu_col(int c) {
    if (c < 1024 || c >= 2048) return c;
    const int ch = (c - 1024) & 511, isg = (c - 1024) >> 9;
    return 1024 + 256 * (ch >> 7) + 128 * isg + (ch & 127);
}
__device__ __forceinline__ void transpose_convert_tile(const float* __restrict__ src, int K, int N, bf16_t* __restrict__ dst, int ldd, int item, bool glu_remap) {
    float* tile = (float*)smem;
    const int ntn = N / 256, tk = item / ntn, tn = item % ntn, t = opaque_tid();
    {
        const int n = t & 255, k0 = t >> 8;
        const float* sp = src + (size_t)(tk * 64 + k0) * N + tn * 256 + n;
        float v[32];
#pragma unroll
        for (int i = 0; i < 32; ++i) v[i] = sp[(size_t)(2 * i) * N];
#pragma unroll
        for (int i = 0; i < 32; ++i) tile[(k0 + 2 * i) * 257 + n] = v[i];
    }
    __syncthreads();
    {
        const int k4 = (t & 15) * 4, n0 = t >> 4;
#pragma unroll
        for (int i = 0; i < 8; ++i) {
            const int n = n0 + 32 * i;
            u32x2 w;
            w.x = cvt_pk_bf16(tile[k4 * 257 + n], tile[(k4 + 1) * 257 + n]);
            w.y = cvt_pk_bf16(tile[(k4 + 2) * 257 + n], tile[(k4 + 3) * 257 + n]);
            *(u32x2*)(dst + (size_t)perm_row(glu_remap ? glu_col(tn * 256 + n) : tn * 256 + n) * ldd + tk * 64 + k4) = w;
        }
    }
    __syncthreads();
}

__device__ __forceinline__ void norm_row_bf16(const float* __restrict__ src, const float* __restrict__ g, bf16_t* __restrict__ dst, int lane) {
    f32x4 v[4]; float ss = 0.f;
#pragma unroll
    for (int i = 0; i < 4; ++i) { v[i] = *(const f32x4*)(src + i * 256 + lane * 4); ss += v[i][0] * v[i][0] + v[i][1] * v[i][1] + v[i][2] * v[i][2] + v[i][3] * v[i][3]; }
    ss = wave_sum(ss);
    const float rstd = rsqrtf(ss * (1.0f / 1024.0f) + EPS);
#pragma unroll
    for (int i = 0; i < 4; ++i) {
        const f32x4 gg = *(const f32x4*)(g + i * 256 + lane * 4);
        *(u32x2*)(dst + i * 256 + lane * 4) = pack4(v[i] * rstd * gg);
    }
}
__device__ __forceinline__ void norm_row_f32(const float* __restrict__ src, const float* __restrict__ g, float* __restrict__ dst, int lane) {
    f32x4 v[4]; float ss = 0.f;
#pragma unroll
    for (int i = 0; i < 4; ++i) { v[i] = *(const f32x4*)(src + i * 256 + lane * 4); ss += v[i][0] * v[i][0] + v[i][1] * v[i][1] + v[i][2] * v[i][2] + v[i][3] * v[i][3]; }
    ss = wave_sum(ss);
    const float rstd = rsqrtf(ss * (1.0f / 1024.0f) + EPS);
#pragma unroll
    for (int i = 0; i < 4; ++i) {
        const f32x4 gg = *(const f32x4*)(g + i * 256 + lane * 4);
        *(f32x4*)(dst + i * 256 + lane * 4) = v[i] * rstd * gg;
    }
}

__device__ __forceinline__ const float* xrow_ptr(const Params& p, int l, int row) {
    if (l == 0) return row < TP ? IN(I_XP) + (size_t)row * DM : IN(I_XS) + (size_t)(row - TP) * DM;
    return (const float*)(WS(p) + W_XN) + (size_t)row * DM;
}

__device__ __forceinline__ void phase_norm(const Params& p, int l) {
    const int w = opaque_tid() >> 6, lane = opaque_tid() & 63;
    bf16_t* Hb = (bf16_t*)(WS(p) + W_H);
    for (int row = blockIdx.x * 8 + w; row < MP; row += gridDim.x * 8) {
        if (row < TT) norm_row_bf16(xrow_ptr(p, l, row), IN(I_NORMG) + l * DM, Hb + (size_t)row * DM, lane);
        else {
#pragma unroll
            for (int i = 0; i < 4; ++i) *(u32x2*)(Hb + (size_t)row * DM + i * 256 + lane * 4) = (u32x2){0u, 0u};
        }
    }
}

__device__ __forceinline__ void convert_weights(const Params& p, int stage, int b0, int nb) {
    const int srcs[8] = {I_WIN, I_WGLU, I_WBRC, I_WBRX, I_WBRS, I_WK, I_WV, I_WOUT};
    const int Ks[8] = {1024, 512, 512, 512, 512, 1024, 1024, 1024};
    const int Ns[8] = {ZW, 512, 1024, 1024, 1024, 512, 512, 1024};
    const int ldds[8] = {1024, 512, 1536, 1536, 1536, 1024, 1024, 1024};
    const size_t offs[8] = {WT_IN, WT_GLU, WT_BR, WT_BR + 512, WT_BR + 1024, WT_K, WT_V, WT_OUT};
    if ((int)blockIdx.x < b0 || (int)blockIdx.x >= b0 + nb) return;
    int base = 0;
#pragma unroll
    for (int l = 0; l < 2; ++l)
#pragma unroll
        for (int i = 0; i < 8; ++i) {
            const bool early = ((i == 0 || i == 1) && l == 0) || i == 5 || i == 6;
            if (early != (stage == 0)) continue;
            const int nt = (Ks[i] / 64) * (Ns[i] / 256);
            const float* src = IN(srcs[i]) + (size_t)l * Ks[i] * Ns[i];
            bf16_t* dst = (bf16_t*)(WS(p) + W_WT) + l * WT_LAYER + offs[i];
            const unsigned G_ = (unsigned)nb; const int first = (int)(((unsigned)((int)blockIdx.x - b0) + G_ - (unsigned)base % G_) % G_);
            for (int it = first; it < nt; it += nb) transpose_convert_tile(src, Ks[i], Ns[i], dst, ldds[i], it, i == 0);
            base += nt;
        }
}
__device__ __forceinline__ void phase_prep(const Params& p) {
    convert_weights(p, 0, 0, gridDim.x);
    const int w = opaque_tid() >> 6, lane = opaque_tid() & 63;
    for (int r = blockIdx.x * 8 + w; r < 2 * 2048; r += gridDim.x * 8) {
        const int l = r >> 11, row = r & 2047;
        norm_row_bf16(IN(I_MEM) + (size_t)row * DM, IN(I_MEMG) + l * DM, (bf16_t*)(WS(p) + W_HM) + (size_t)r * DM, lane);
    }
    phase_norm(p, 0);
}

__device__ __forceinline__ int in_act(int col) {
    if (col < 512) return 0; if (col < 1024) return 1; if (col < 2048) return 3;
    if (col < 2560) return 1; if (col < 3072) return 0; if (col < 3584) return 1; return 2;
}
typedef f32x4 Acc[2][2][4][2];
#define FOR_AI  _Pragma("unroll") for (int ai = 0; ai < 2; ++ai)
#define FOR_MB _Pragma("unroll") for (int m = 0; m < 4; ++m) _Pragma("unroll") for (int bj = 0; bj < 2; ++bj)
__device__ __forceinline__ u32x4 pack8(f32x4 a, f32x4 b) { u32x4 w; w.x = cvt_pk_bf16(a[0], a[1]); w.y = cvt_pk_bf16(a[2], a[3]); w.z = cvt_pk_bf16(b[0], b[1]); w.w = cvt_pk_bf16(b[2], b[3]); return w; }
__device__ __forceinline__ f32x4 unlo(u32x4 w) { return (f32x4){bflo(w.x), bfhi(w.x), bflo(w.y), bfhi(w.y)}; }
__device__ __forceinline__ f32x4 unhi(u32x4 w) { return (f32x4){bflo(w.z), bfhi(w.z), bflo(w.w), bfhi(w.w)}; }
__device__ __forceinline__ f32x4 sig4(f32x4 v) { return (f32x4){sigmoidf_(v[0]), sigmoidf_(v[1]), sigmoidf_(v[2]), sigmoidf_(v[3])}; }
__device__ __forceinline__ f32x4 silu4(f32x4 v) { return (f32x4){siluf_(v[0]), siluf_(v[1]), siluf_(v[2]), siluf_(v[3])}; }
__device__ __forceinline__ f32x4 gcl4(f32x4 v) { return (f32x4){fmaxf(v[0], 1e-30f), fmaxf(v[1], 1e-30f), fmaxf(v[2], 1e-30f), fmaxf(v[3], 1e-30f)}; }
__device__ __forceinline__ f32x4 rcp4(f32x4 v) { return (f32x4){__builtin_amdgcn_rcpf(v[0]), __builtin_amdgcn_rcpf(v[1]), __builtin_amdgcn_rcpf(v[2]), __builtin_amdgcn_rcpf(v[3])}; }
struct EpiIn {
    static constexpr bool HOOK = false, INIT = false; static constexpr int WAITK = -1;
    bf16_t* Z;
    __device__ __forceinline__ void operator()(Acc& acc, int row0, int col0) const {
        const int act = in_act(col0);
        if (act == 3) {
            const int vcol = C_UB + (((col0 & ~255) - 1024) >> 1) + (col0 & 255);
            FOR_AI {
#pragma unroll
                for (int m = 0; m < 4; ++m)
                    *(u32x4*)(Z + zoff(row0 + ai * 128 + m * 16, vcol)) = pack8(acc[ai][0][m][0] * sig4(acc[ai][1][m][0]), acc[ai][0][m][1] * sig4(acc[ai][1][m][1]));
            }
            return;
        }
        FOR_AI FOR_MB {
            f32x4 v0 = acc[ai][bj][m][0], v1 = acc[ai][bj][m][1];
            if (act == 1) { v0 = silu4(v0); v1 = silu4(v1); }
            else if (act == 2) { v0 = sig4(v0); v1 = sig4(v1); }
            *(u32x4*)(Z + zoff(row0 + ai * 128 + m * 16, col0 + bj * 128)) = pack8(v0, v1);
        }
    }
};
struct EpiKV {
    static constexpr bool HOOK = false, INIT = false; static constexpr int WAITK = -1;
    float* outf; bf16_t* kb; bf16_t* vt; int isV;
    __device__ __forceinline__ void operator()(Acc& acc, int row0, int col0) const {
        FOR_AI FOR_MB {
            const f32x4 v0 = acc[ai][bj][m][0], v1 = acc[ai][bj][m][1];
            const int row = row0 + ai * 128 + m * 16, col = col0 + bj * 128;
            *(f32x4*)(outf + (size_t)row * 512 + col) = v0; *(f32x4*)(outf + (size_t)row * 512 + col + 4) = v1;
            if (!isV) *(u32x4*)(kb + (size_t)row * 512 + col) = pack8(v0, v1);
            else {
                const int b = row >> 8, mm = row & 255, head = col >> 7, d = col & 127;
                bf16_t* q = vt + ((size_t)((b * 4 + head) * 128 + d)) * 256 + mm;
                q[0] = f2bf(v0[0]); q[256] = f2bf(v0[1]); q[512] = f2bf(v0[2]); q[768] = f2bf(v0[3]);
                q[1024] = f2bf(v1[0]); q[1280] = f2bf(v1[1]); q[1536] = f2bf(v1[2]); q[1792] = f2bf(v1[3]);
            }
        }
    }
};
struct EpiGlu {
    static constexpr bool HOOK = false, INIT = false; static constexpr int WAITK = -1;
    const bf16_t* Ya; const bf16_t* Z; const float* bias; bf16_t* ABR;
    __device__ __forceinline__ void operator()(Acc& acc, int row0, int col0) const {
        f32x4 bv[2][2];
#pragma unroll
        for (int bj = 0; bj < 2; ++bj) { bv[bj][0] = *(const f32x4*)(bias + col0 + bj * 128); bv[bj][1] = *(const f32x4*)(bias + col0 + bj * 128 + 4); }
        FOR_AI {
            u32x4 ya[4][2], za[4][2];
            FOR_MB {
                const int row = row0 + ai * 128 + m * 16, col = col0 + bj * 128;
                ya[m][bj] = *(const u32x4*)(Ya + (size_t)row * 512 + col);
                za[m][bj] = *(const u32x4*)(Z + zoff(row, C_ZA + col));
            }
            FOR_MB {
                const int row = row0 + ai * 128 + m * 16, col = col0 + bj * 128;
                const f32x4 o0 = unlo(ya[m][bj]) * sig4(acc[ai][bj][m][0] + bv[bj][0]) * unlo(za[m][bj]);
                const f32x4 o1 = unhi(ya[m][bj]) * sig4(acc[ai][bj][m][1] + bv[bj][1]) * unhi(za[m][bj]);
                *(u32x4*)(ABR + (size_t)row * 1536 + 1024 + col) = pack8(o0, o1);
            }
        }
    }
};
__device__ __forceinline__ float gclamp(float g) { return fmaxf(g, 1e-30f); }
struct EpiBr3 {
    static constexpr bool HOOK = true, INIT = false; static constexpr int WAITK = 14;
    const bf16_t* Z; bf16_t* Mb; unsigned* cnt;
    __device__ __forceinline__ void wait_k(int pm, int wid) const {
        if (wid == 0) {
            if ((threadIdx.x & 63) == 0) { unsigned sp = 0; while (__hip_atomic_load(cnt + pm, __ATOMIC_RELAXED, __HIP_MEMORY_SCOPE_AGENT) < 2u) { __builtin_amdgcn_s_sleep(2); if (++sp > (1u << 22)) break; } }
            __builtin_amdgcn_fence(__ATOMIC_ACQUIRE, "agent");
            asm volatile("s_waitcnt vmcnt(0)" ::: "memory");
        }
        asm volatile("" ::: "memory"); __builtin_amdgcn_s_barrier(); asm volatile("" ::: "memory");
    }
    __device__ __forceinline__ void hook(int t, Acc& acc, int row0, int col0) const {
        const int cn = (t == 8) ? C_GB : C_GX, cd = (t == 8) ? C_GX : C_GA;
        asm volatile("" : "+v"(row0));
        const char* Zc = (const char*)Z;
        FOR_AI {
            u32x4 gn[4][2], gd[4][2];
            FOR_MB {
                const size_t o = zoff(row0 + ai * 128 + m * 16, col0 + bj * 128) * 2;
                gn[m][bj] = *(const u32x4*)(Zc + o + zoff(0, cn) * 2); gd[m][bj] = *(const u32x4*)(Zc + o + zoff(0, cd) * 2);
            }
            FOR_MB {
                acc[ai][bj][m][0] *= gcl4(unlo(gn[m][bj])) * rcp4(gcl4(unlo(gd[m][bj])));
                acc[ai][bj][m][1] *= gcl4(unhi(gn[m][bj])) * rcp4(gcl4(unhi(gd[m][bj])));
            }
        }
    }
    __device__ __forceinline__ void operator()(Acc& acc, int row0, int col0) const {
        FOR_AI {
            u32x4 ga[4][2];
            FOR_MB ga[m][bj] = *(const u32x4*)(Z + zoff(row0 + ai * 128 + m * 16, C_GA + col0 + bj * 128));
            FOR_MB {
                const f32x4 v0 = acc[ai][bj][m][0] * gcl4(unlo(ga[m][bj])), v1 = acc[ai][bj][m][1] * gcl4(unhi(ga[m][bj]));
                *(u32x4*)(Mb + (size_t)(row0 + ai * 128 + m * 16) * DM + col0 + bj * 128) = pack8(v0, v1);
            }
        }
    }
};
struct EpiOut {
    static constexpr bool HOOK = false, INIT = true; static constexpr int WAITK = -1;
    const float* src; float* dst;
    __device__ __forceinline__ void init(Acc& acc, int row0, int col0) const {
        FOR_AI FOR_MB {
            const float* q = src + (size_t)(row0 + ai * 128 + m * 16) * DM + col0 + bj * 128;
            acc[ai][bj][m][0] = *(const f32x4*)q; acc[ai][bj][m][1] = *(const f32x4*)(q + 4);
        }
    }
    __device__ __forceinline__ void operator()(Acc& acc, int row0, int col0) const {
        FOR_AI FOR_MB {
            float* q = dst + (size_t)(row0 + ai * 128 + m * 16) * DM + col0 + bj * 128;
            *(f32x4*)q = acc[ai][bj][m][0]; *(f32x4*)(q + 4) = acc[ai][bj][m][1];
        }
    }
};

__device__ __forceinline__ void phase_inproj(const Params& p, int l) {
    const bf16_t* Hb = (const bf16_t*)(WS(p) + W_H);
    const bf16_t* Wt = (const bf16_t*)(WS(p) + W_WT) + l * WT_LAYER;
    bf16_t* Z = (bf16_t*)(WS(p) + W_Z);
    const int G = gridDim.x;
    {
        Sched S; S.init(MP / 256, ZW / 256, G, blockIdx.x);
        EpiIn e{Z};
        gemm_phase(Gemm{Hb, Wt + WT_IN, DM}, S, e);
    }
    if (l == 0) {
#pragma unroll 1
        for (int k = 0; k < 4; ++k) {
            const int ll = k >> 1, isV = k & 1;
            const int c = (int)((blockIdx.x + 4u * G - 154u - 16u * k) % (unsigned)G);
            Sched S; S.init(8, 2, G, c);
            const bf16_t* Hm = (const bf16_t*)(WS(p) + W_HM) + (size_t)ll * 2048 * DM;
            const bf16_t* W = (const bf16_t*)(WS(p) + W_WT) + ll * WT_LAYER + (isV ? WT_V : WT_K);
            EpiKV e{OUTP() + (isV ? O_PV : O_PK) + (size_t)ll * 2048 * 512, (bf16_t*)(WS(p) + W_KB) + (size_t)ll * 2048 * 512, (bf16_t*)(WS(p) + W_VT) + (size_t)ll * 2048 * 512, isV};
            gemm_phase(Gemm{Hm, W, DM}, S, e);
        }
    }
}

__device__ __forceinline__ void phase_glu(const Params& p, int l) {
    const bf16_t* Wt = (const bf16_t*)(WS(p) + W_WT) + l * WT_LAYER;
    Sched S; S.init(MP / 256, 2, gridDim.x, blockIdx.x);
    EpiGlu e{(const bf16_t*)(WS(p) + W_YA), (const bf16_t*)(WS(p) + W_Z), IN(I_BGLU) + l * 512, (bf16_t*)(WS(p) + W_ABR)};
    gemm_phase(Gemm{(const bf16_t*)(WS(p) + W_YA), Wt + WT_GLU, 512}, S, e);
}
template <int K, bool HOOKS, class Epi>
__device__ __forceinline__ void skinny_gemm(const bf16_t* __restrict__ A, const bf16_t* __restrict__ Bt, int cb, const Epi& E) {
    const int tid = opaque_tid(), w = tid >> 6, lane = tid & 63, fr = lane & 15, fq = lane >> 4;
    const bf16_t* ap = A + (size_t)(16 * w + fr) * K + 8 * fq;
    const bf16_t* bp = Bt + (size_t)(16 * cb + fr) * K + 8 * fq;
    f32x4 acc = {0.f, 0.f, 0.f, 0.f};
#pragma unroll 1
    for (int k0 = 0; k0 < K; k0 += 512) {
        if constexpr (HOOKS) { if (k0 == 512 || k0 == 1024) E.hook(k0, acc, 16 * w + fr, 32 * (cb >> 1) + 8 * fq + 4 * (cb & 1)); }
        bf16x8 af[16], bf[16];
#pragma unroll
        for (int i = 0; i < 16; ++i) { af[i] = *(const bf16x8*)(ap + k0 + 32 * i); bf[i] = *(const bf16x8*)(bp + k0 + 32 * i); }
#pragma unroll
        for (int i = 0; i < 16; ++i) acc = __builtin_amdgcn_mfma_f32_16x16x32_bf16(bf[i], af[i], acc, 0, 0, 0);
    }
    E(acc, 16 * w + fr, 32 * (cb >> 1) + 8 * fq + 4 * (cb & 1));
}
struct EpiBrS {
    const bf16_t* Z; bf16_t* Mb;
    __device__ __forceinline__ void hook(int k0, f32x4& acc, int r, int col) const {
        const int cn = (k0 == 512) ? C_GB : C_GX, cd = (k0 == 512) ? C_GX : C_GA;
        const u32x2 a = *(const u32x2*)(Z + zoff(TP + r, cn + col)), d = *(const u32x2*)(Z + zoff(TP + r, cd + col));
        acc[0] *= gclamp(bflo(a.x)) * __builtin_amdgcn_rcpf(gclamp(bflo(d.x))); acc[1] *= gclamp(bfhi(a.x)) * __builtin_amdgcn_rcpf(gclamp(bfhi(d.x)));
        acc[2] *= gclamp(bflo(a.y)) * __builtin_amdgcn_rcpf(gclamp(bflo(d.y))); acc[3] *= gclamp(bfhi(a.y)) * __builtin_amdgcn_rcpf(gclamp(bfhi(d.y)));
    }
    __device__ __forceinline__ void operator()(f32x4 acc, int r, int col) const {
        const u32x2 a = *(const u32x2*)(Z + zoff(TP + r, C_GA + col));
        acc[0] *= gclamp(bflo(a.x)); acc[1] *= gclamp(bfhi(a.x)); acc[2] *= gclamp(bflo(a.y)); acc[3] *= gclamp(bfhi(a.y));
        *(u32x2*)(Mb + (size_t)(TP + r) * DM + col) = pack4(acc);
    }
};
struct EpiOutS {
    const float* src; float* dst;
    __device__ __forceinline__ void operator()(f32x4 acc, int r, int col) const {
        *(f32x4*)(dst + (size_t)r * DM + col) = *(const f32x4*)(src + (size_t)r * DM + col) + acc;
    }
};
__device__ __forceinline__ void phase_glu_br(const Params& p, int l) {
    const bf16_t* Wt = (const bf16_t*)(WS(p) + W_WT) + l * WT_LAYER;
    const int G = gridDim.x, bx = blockIdx.x;
    unsigned* cnt = (unsigned*)(WS(p) + W_CNT) + l * 80;
#pragma unroll 1
    for (int u = bx; u < 130; u += G) {
        Sched S; S.init_single(u >> 1, u & 1);
        EpiGlu e{(const bf16_t*)(WS(p) + W_YA), (const bf16_t*)(WS(p) + W_Z), IN(I_BGLU) + l * 512, (bf16_t*)(WS(p) + W_ABR)};
        gemm_phase(Gemm{(const bf16_t*)(WS(p) + W_YA), Wt + WT_GLU, 512}, S, e);
        signal_done(cnt + (u >> 1));
    }
    {
        Sched S; S.init(TP / 256, 4, G, bx);
        EpiBr3 e{(const bf16_t*)(WS(p) + W_Z), (bf16_t*)(WS(p) + W_H), cnt};
        gemm_phase(Gemm{(const bf16_t*)(WS(p) + W_ABR), Wt + WT_BR, 1536}, S, e);
    }
#pragma unroll 1
    for (int cb = (int)((bx + 64u * (unsigned)G - (unsigned)(G >= 64 ? G - 64 : 0)) % (unsigned)G); cb < 64; cb += G) {
        wait_count(cnt + 64, 2u);
        EpiBrS e{(const bf16_t*)(WS(p) + W_Z), (bf16_t*)(WS(p) + W_H)};
        skinny_gemm<1536, true>((const bf16_t*)(WS(p) + W_ABR) + (size_t)TP * 1536, Wt + WT_BR, cb, e);
    }
}
__device__ __forceinline__ void phase_out(const Params& p, int l) {
    const bf16_t* Wt = (const bf16_t*)(WS(p) + W_WT) + l * WT_LAYER;
    {
        Sched S; S.init(TP / 256, 4, gridDim.x, blockIdx.x);
        EpiOut e{l == 0 ? IN(I_XP) : (const float*)(WS(p) + W_XN), (float*)(WS(p) + W_XN)};
        gemm_phase(Gemm{(const bf16_t*)(WS(p) + W_H), Wt + WT_OUT, DM}, S, e);
    }
    for (int cb = blockIdx.x; cb < 64; cb += gridDim.x) {
        float* xs_new = (float*)(WS(p) + W_XN) + (size_t)TP * DM;
        EpiOutS e{l == 0 ? IN(I_XS) : (const float*)xs_new, xs_new};
        skinny_gemm<1024, false>((const bf16_t*)(WS(p) + W_H) + (size_t)TP * DM, Wt + WT_OUT, cb, e);
    }
}
__device__ __forceinline__ void phase_final(const Params& p) {
    const int w = opaque_tid() >> 6, lane = opaque_tid() & 63;
    const float* xn = (const float*)(WS(p) + W_XN);
    for (int row = blockIdx.x * 8 + w; row < TT; row += gridDim.x * 8)
        norm_row_f32(xn + (size_t)row * DM, IN(I_FING), OUTP() + (row < TP ? O_YP + (size_t)row * DM : O_YS + (size_t)(row - TP) * DM), lane);
}

struct SsmCoef { float lr, li, cr, ci; };
__device__ __forceinline__ SsmCoef ssm_coef(const Params& p, int l, int g, int pp) {
    const float are = IN(I_ARE)[(l * 32 + g) * 64 + pp], aim = IN(I_AIM)[(l * 32 + g) * 64 + pp];
    const float dt = expf(IN(I_LOGDT)[l * 32 + g]);
    const float er = expf(are * dt);
    const double x = (double)aim * (double)dt;
    const double k = rint(x * 0.15915494309189535);
    const float r = (float)(x - k * 6.283185307179586);
    const float sn = sinf(r), cs = cosf(r);
    SsmCoef c; c.lr = er * cs; c.li = er * sn;
    const float nr = c.lr - 1.0f, ni = c.li, den = 1.0f / (are * are + aim * aim);
    c.cr = (nr * are + ni * aim) * den; c.ci = (ni * are - nr * aim) * den;
    return c;
}

constexpr int SSM_BPS = 528, SSM_CPS = 272;
constexpr int SSM_KM = 75776, SSM_BB = SSM_KM + 17 * 256 * 2, SSM_SIN = SSM_BB + 16 * 272, SSM_FIN = SSM_SIN + 8 * 16 * 272;
__device__ __forceinline__ void ssm_prompt_task(const Params& p, int l, int b, int g) {
    const int tid = opaque_tid(), w = tid >> 6, lane = tid & 63, fr = lane & 15, fq = lane >> 4;
    LAS unsigned char* RA = (LAS unsigned char*)smem;
    LAS unsigned char* KmL = (LAS unsigned char*)smem + SSM_KM;
    LAS unsigned char* BbT = (LAS unsigned char*)smem + SSM_BB;
    LAS unsigned char* SinL = (LAS unsigned char*)smem + SSM_SIN + w * (16 * 272);
    LAS float* fin = (LAS float*)((LAS unsigned char*)smem + SSM_FIN);
    const bf16_t* Z = (const bf16_t*)(WS(p) + W_Z);
    bf16_t* Ya = (bf16_t*)(WS(p) + W_YA);
    const size_t zrow0 = (size_t)b * SEQ + w * 256;
    bf16x8 uf[8];
#pragma unroll
    for (int s8 = 0; s8 < 8; ++s8) uf[s8] = *(const bf16x8*)(Z + zoff(zrow0 + 16 * fr + 2 * s8 + (fq >> 1), C_UA + g * 16 + 8 * (fq & 1)));
    float ccr[16], cci[16];
    {
        const float* crp = IN(I_CRE) + ((size_t)(l * 32 + g) * 16) * 64 + lane;
        const float* cip = IN(I_CIM) + ((size_t)(l * 32 + g) * 16) * 64 + lane;
#pragma unroll
        for (int h = 0; h < 16; ++h) { ccr[h] = crp[h * 64]; cci[h] = cip[h * 64]; }
    }
    const f32x4 dv = *(const f32x4*)(IN(I_D) + l * 512 + g * 16 + 4 * fq);
    const SsmCoef me = ssm_coef(p, l, g, lane);
    {
        const float* brp = IN(I_BRE) + ((size_t)(l * 32 + g) * 64 + lane) * 16;
        const float* bip = IN(I_BIM) + ((size_t)(l * 32 + g) * 64 + lane) * 16;
        float bbr[16], bbi[16];
#pragma unroll
        for (int q4 = 0; q4 < 4; ++q4) {
            const f32x4 vr = *(const f32x4*)(brp + 4 * q4), vi = *(const f32x4*)(bip + 4 * q4);
#pragma unroll
            for (int e = 0; e < 4; ++e) { bbr[4 * q4 + e] = me.cr * vr[e] - me.ci * vi[e]; bbi[4 * q4 + e] = me.cr * vi[e] + me.ci * vr[e]; }
        }
#pragma unroll
        for (int e = 0; e < 16; ++e) if ((e >> 1) == w) *(LAS unsigned*)(BbT + e * 272 + 4 * lane) = cvt_pk_bf16(bbr[e], bbi[e]);
        float qr = 1.f, qi = 0.f;
        for (int i2 = 0; i2 < 14 - 2 * w; ++i2) { const float a = qr * me.lr - qi * me.li, c2 = qr * me.li + qi * me.lr; qr = a; qi = c2; }
#pragma unroll
        for (int tsel = 0; tsel < 2; ++tsel) {
            const int tp = 2 * w + 1 - tsel;
            if (tsel == 1) { const float a = qr * me.lr - qi * me.li, c2 = qr * me.li + qi * me.lr; qr = a; qi = c2; }
#pragma unroll
            for (int e = 0; e < 16; e += 2) {
                const float r0 = qr * bbr[e] - qi * bbi[e], i0 = qr * bbi[e] + qi * bbr[e];
                const float r1 = qr * bbr[e + 1] - qi * bbi[e + 1], i1 = qr * bbi[e + 1] + qi * bbr[e + 1];
                *(LAS unsigned*)(RA + (2 * lane) * SSM_BPS + (16 * tp + e) * 2) = cvt_pk_bf16(r0, r1);
                *(LAS unsigned*)(RA + (2 * lane + 1) * SSM_BPS + (16 * tp + e) * 2) = cvt_pk_bf16(i0, i1);
            }
        }
    }
    __syncthreads();
    f32x4 a1[8];
#pragma unroll
    for (int j = 0; j < 8; ++j) {
        f32x4 a = {0.f, 0.f, 0.f, 0.f};
#pragma unroll
        for (int s8 = 0; s8 < 8; ++s8) {
            const bf16x8 bf = *(const LAS bf16x8*)(RA + (16 * j + fr) * SSM_BPS + (32 * s8 + 8 * fq) * 2);
            a = __builtin_amdgcn_mfma_f32_16x16x32_bf16(uf[s8], bf, a, 0, 0, 0);
        }
        a1[j] = a;
    }
    __syncthreads();
    LAS float* SL = (LAS float*)(RA + w * (16 * 132 * 4));
#pragma unroll
    for (int j = 0; j < 8; ++j)
#pragma unroll
        for (int r = 0; r < 4; ++r) SL[(4 * fq + r) * 132 + 16 * j + fr] = a1[j][r];
    float l16r = me.lr, l16i = me.li;
#pragma unroll
    for (int i2 = 0; i2 < 4; ++i2) { const float a = l16r * l16r - l16i * l16i, c2 = 2.f * l16r * l16i; l16r = a; l16i = c2; }
    float l256r = l16r, l256i = l16i;
#pragma unroll
    for (int i2 = 0; i2 < 4; ++i2) { const float a = l256r * l256r - l256i * l256i, c2 = 2.f * l256r * l256i; l256r = a; l256i = c2; }
    f32x2 sl[16];
#pragma unroll
    for (int sc = 0; sc < 16; ++sc) sl[sc] = *(const LAS f32x2*)(SL + sc * 132 + 2 * lane);
    {
        float er = 0.f, ei = 0.f;
#pragma unroll
        for (int sc = 0; sc < 16; ++sc) { const float a = l16r * er - l16i * ei + sl[sc].x, c2 = l16r * ei + l16i * er + sl[sc].y; er = a; ei = c2; }
        fin[(w * 64 + lane) * 2] = er; fin[(w * 64 + lane) * 2 + 1] = ei;
    }
    __syncthreads();
    {
        float cr = 0.f, ci = 0.f;
        for (int ww = 0; ww < w; ++ww) {
            const float fr_ = fin[(ww * 64 + lane) * 2], fi_ = fin[(ww * 64 + lane) * 2 + 1];
            const float a = l256r * cr - l256i * ci + fr_, c2 = l256r * ci + l256i * cr + fi_;
            cr = a; ci = c2;
        }
#pragma unroll
        for (int sc = 0; sc < 16; ++sc) {
            *(LAS unsigned*)(SinL + sc * 272 + 4 * lane) = cvt_pk_bf16(cr, ci);
            const float a = l16r * cr - l16i * ci + sl[sc].x, c2 = l16r * ci + l16i * cr + sl[sc].y; cr = a; ci = c2;
        }
        if (w == 7) {
            OUTP()[O_PRE + ((size_t)(l * 8 + b) * 32 + g) * 64 + lane] = cr;
            OUTP()[O_PIM + ((size_t)(l * 8 + b) * 32 + g) * 64 + lane] = ci;
        }
    }
    __syncthreads();
    {
        float l8r = me.lr, l8i = me.li;
#pragma unroll
        for (int i2 = 0; i2 < 3; ++i2) { const float a = l8r * l8r - l8i * l8i, c2 = 2.f * l8r * l8i; l8r = a; l8i = c2; }
        float qr = 1.f, qi = 0.f;
        for (int i2 = 0; i2 < w; ++i2) { const float a = qr * me.lr - qi * me.li, c2 = qr * me.li + qi * me.lr; qr = a; qi = c2; }
        const int ntau = (w == 0) ? 3 : 2;
        for (int it = 0; it < ntau; ++it) {
            const int tau = w + 8 * it;
#pragma unroll
            for (int h = 0; h < 16; ++h) {
                const float zr = ccr[h] * qr - cci[h] * qi, zi = ccr[h] * qi + cci[h] * qr;
                *(LAS unsigned*)(RA + (tau * 16 + h) * SSM_CPS + 4 * lane) = cvt_pk_bf16(zr, -zi);
            }
            const float a = qr * l8r - qi * l8i, c2 = qr * l8i + qi * l8r; qr = a; qi = c2;
        }
        if (tid < 128) *(LAS unsigned*)(KmL + 16 * 512 + 4 * tid) = 0u;
    }
    __syncthreads();
    {
        bf16x8 bb[4];
#pragma unroll
        for (int s4 = 0; s4 < 4; ++s4) bb[s4] = *(const LAS bf16x8*)(BbT + fr * 272 + (32 * s4 + 8 * fq) * 2);
#pragma unroll
        for (int tt2 = 0; tt2 < 2; ++tt2) {
            const int tau = 2 * w + tt2;
            f32x4 a = {0.f, 0.f, 0.f, 0.f};
#pragma unroll
            for (int s4 = 0; s4 < 4; ++s4) {
                const bf16x8 cf = *(const LAS bf16x8*)(RA + (tau * 16 + fr) * SSM_CPS + (32 * s4 + 8 * fq) * 2);
                a = __builtin_amdgcn_mfma_f32_16x16x32_bf16(cf, bb[s4], a, 0, 0, 0);
            }
#pragma unroll
            for (int r = 0; r < 4; ++r) *(LAS bf16_t*)(KmL + ((tau * 16 + 4 * fq + r) * 16 + fr) * 2) = f2bf_sw(a[r]);
        }
    }
    __syncthreads();
    {
        bf16x8 sf[4];
#pragma unroll
        for (int s4 = 0; s4 < 4; ++s4) sf[s4] = *(const LAS bf16x8*)(SinL + fr * 272 + (32 * s4 + 8 * fq) * 2);
#pragma unroll
        for (int half = 0; half < 2; ++half) {
            f32x4 acc[8];
            u32x2 uu[8];
#pragma unroll
            for (int jj = 0; jj < 8; ++jj) {
                const int j = half * 8 + jj;
                uu[jj] = *(const u32x2*)(Z + zoff(zrow0 + 16 * fr + j, C_UA + g * 16 + 4 * fq));
                f32x4 a = {0.f, 0.f, 0.f, 0.f};
#pragma unroll
                for (int s4 = 0; s4 < 4; ++s4) {
                    const bf16x8 cf = *(const LAS bf16x8*)(RA + ((j + 1) * 16 + fr) * SSM_CPS + (32 * s4 + 8 * fq) * 2);
                    a = __builtin_amdgcn_mfma_f32_16x16x32_bf16(cf, sf[s4], a, 0, 0, 0);
                }
#pragma unroll
                for (int s8 = 0; s8 < 8; ++s8) {
                    if (2 * s8 <= j) {
                        int tau = j - 2 * s8 - (fq >> 1); tau = tau < 0 ? 16 : tau;
                        const bf16x8 tf = *(const LAS bf16x8*)(KmL + (tau * 16 + fr) * 32 + 16 * (fq & 1));
                        a = __builtin_amdgcn_mfma_f32_16x16x32_bf16(tf, uf[s8], a, 0, 0, 0);
                    }
                }
                acc[jj] = a;
            }
#pragma unroll
            for (int jj = 0; jj < 8; ++jj) {
                const int j = half * 8 + jj;
                f32x4 o;
                o[0] = gelu_tanh(acc[jj][0] + dv[0] * bflo(uu[jj].x)); o[1] = gelu_tanh(acc[jj][1] + dv[1] * bfhi(uu[jj].x));
                o[2] = gelu_tanh(acc[jj][2] + dv[2] * bflo(uu[jj].y)); o[3] = gelu_tanh(acc[jj][3] + dv[3] * bfhi(uu[jj].y));
                *(u32x2*)(Ya + (zrow0 + 16 * fr + j) * 512 + g * 16 + 4 * fq) = pack4(o);
            }
        }
    }
    __syncthreads();
}

__device__ __forceinline__ void ssm_sample_task(const Params& p, int l, int item) {
    const int tid = opaque_tid(), w = tid >> 6, lane = tid & 63;
    const bf16_t* Z = (const bf16_t*)(WS(p) + W_Z);
    bf16_t* Ya = (bf16_t*)(WS(p) + W_YA);
    const int wi = item * 8 + w, g = wi & 31, bs0 = wi >> 5;
    const float* brp = IN(I_BRE) + ((size_t)(l * 32 + g) * 64 + lane) * 16;
    const float* bip = IN(I_BIM) + ((size_t)(l * 32 + g) * 64 + lane) * 16;
    f32x4 vbr[4], vbi[4], vd[4];
#pragma unroll
    for (int k = 0; k < 4; ++k) { vbr[k] = *(const f32x4*)(brp + 4 * k); vbi[k] = *(const f32x4*)(bip + 4 * k); vd[k] = *(const f32x4*)(IN(I_D) + l * 512 + g * 16 + 4 * k); }
    const float* crp = IN(I_CRE) + ((size_t)(l * 32 + g) * 16) * 64 + lane;
    const float* cip = IN(I_CIM) + ((size_t)(l * 32 + g) * 16) * 64 + lane;
    float ccr[16], cci[16];
#pragma unroll
    for (int h = 0; h < 16; ++h) { ccr[h] = crp[h * 64]; cci[h] = cip[h * 64]; }
    u32x4 u0[2], u1[2]; float s0r[2], s0i[2];
#pragma unroll
    for (int q = 0; q < 2; ++q) {
        const int bs = bs0 + 64 * q; const size_t row = (size_t)TP + bs;
        const size_t sidx = ((size_t)(l * 128 + bs) * 32 + g) * 64 + lane;
        u0[q] = *(const u32x4*)(Z + zoff(row, C_UA + g * 16)); u1[q] = *(const u32x4*)(Z + zoff(row, C_UA + g * 16 + 8));
        s0r[q] = IN(I_SRE)[sidx]; s0i[q] = IN(I_SIM)[sidx];
    }
    const SsmCoef me = ssm_coef(p, l, g, lane);
    float bbr[16], bbi[16];
#pragma unroll
    for (int h = 0; h < 16; ++h) {
        const float vr = vbr[h >> 2][h & 3], vi = vbi[h >> 2][h & 3];
        bbr[h] = me.cr * vr - me.ci * vi; bbi[h] = me.cr * vi + me.ci * vr;
    }
#pragma unroll
    for (int q = 0; q < 2; ++q) {
        const int bs = bs0 + 64 * q; const size_t row = (size_t)TP + bs;
        const size_t sidx = ((size_t)(l * 128 + bs) * 32 + g) * 64 + lane;
        float u[16];
        { const f32x4 a = unlo(u0[q]), b2 = unhi(u0[q]), c = unlo(u1[q]), d2 = unhi(u1[q]);
#pragma unroll
          for (int e = 0; e < 4; ++e) { u[e] = a[e]; u[4 + e] = b2[e]; u[8 + e] = c[e]; u[12 + e] = d2[e]; } }
        float bur = 0.f, bui = 0.f;
#pragma unroll
        for (int h = 0; h < 16; ++h) { bur += bbr[h] * u[h]; bui += bbi[h] * u[h]; }
        const float sr = me.lr * s0r[q] - me.li * s0i[q] + bur, si = me.lr * s0i[q] + me.li * s0r[q] + bui;
        float myy = 0.f;
#pragma unroll
        for (int h = 0; h < 16; ++h) {
            float y = wave_sum(sr * ccr[h] - si * cci[h]);
            y += vd[h >> 2][h & 3] * u[h];
            if (lane == h) myy = y;
        }
        OUTP()[O_SRE + sidx] = sr; OUTP()[O_SIM + sidx] = si;
        if (lane < 16) Ya[row * 512 + g * 16 + lane] = f2bf(gelu_tanh(myy));
    }
}

__device__ __forceinline__ void conv_ln_rows(const Params& p, int l, const float* co, size_t row, int lane, int w, u32x4 zb) {
    const bf16_t* Z = (const bf16_t*)(WS(p) + W_Z);
    bf16_t* Cb = (bf16_t*)(WS(p) + W_ABR);
    const f32x4 a0 = *(const f32x4*)(co + w * 512 + lane * 8), a1 = *(const f32x4*)(co + w * 512 + lane * 8 + 4);
    float s = (a0[0] + a0[1]) + (a0[2] + a0[3]) + (a1[0] + a1[1]) + (a1[2] + a1[3]);
    s = wave_sum(s);
    const float mu = s * (1.0f / 512.0f);
    const f32x4 d0 = a0 - mu, d1 = a1 - mu;
    float q = d0[0] * d0[0] + d0[1] * d0[1] + d0[2] * d0[2] + d0[3] * d0[3] + d1[0] * d1[0] + d1[1] * d1[1] + d1[2] * d1[2] + d1[3] * d1[3];
    q = wave_sum(q);
    const float rstd = rsqrtf(q * (1.0f / 512.0f) + EPS);
    const float* lg = IN(I_LNG) + l * 512 + lane * 8; const float* lb = IN(I_LNB) + l * 512 + lane * 8;
    const f32x4 g0 = *(const f32x4*)lg, g1 = *(const f32x4*)(lg + 4), b0 = *(const f32x4*)lb, b1 = *(const f32x4*)(lb + 4);
    f32x4 o0 = d0 * rstd * g0 + b0, o1 = d1 * rstd * g1 + b1;
    u32x4 wv;
    wv.x = cvt_pk_bf16(siluf_(o0[0]) * bflo(zb.x), siluf_(o0[1]) * bfhi(zb.x));
    wv.y = cvt_pk_bf16(siluf_(o0[2]) * bflo(zb.y), siluf_(o0[3]) * bfhi(zb.y));
    wv.z = cvt_pk_bf16(siluf_(o1[0]) * bflo(zb.z), siluf_(o1[1]) * bfhi(zb.z));
    wv.w = cvt_pk_bf16(siluf_(o1[2]) * bflo(zb.w), siluf_(o1[3]) * bfhi(zb.w));
    *(u32x4*)(Cb + row * 1536 + lane * 8) = wv;
}

__device__ __forceinline__ void conv_prompt_task(const Params& p, int l, int b, int tile) {
    const int c = opaque_tid(), w = c >> 6, lane = c & 63;
    bf16_t* vt = (bf16_t*)smem;
    float* co = (float*)(smem + 94 * 512 * 2);
    const bf16_t* Z = (const bf16_t*)(WS(p) + W_Z);
    const int t0 = tile * 64;
    float wk[31];
#pragma unroll
    for (int k = 0; k < 31; ++k) wk[k] = IN(I_CONVW)[(size_t)(l * 31 + k) * 512 + c];
    const float bias = IN(I_CONVB)[l * 512 + c];
    u32x4 zbv[8];
#pragma unroll
    for (int i = 0; i < 8; ++i) zbv[i] = *(const u32x4*)(Z + zoff((size_t)b * SEQ + t0 + (i >> 1) * 16 + (i & 1) * 8 + w, C_ZB + lane * 8));
    {
        u32x4 av[12];
#pragma unroll
        for (int i = 0; i < 12; ++i) {
            const int rr = w + 8 * i, t = t0 - 30 + rr;
            const bool ok = (t >= 0) && (rr < 94);
            const size_t row = (size_t)b * SEQ + (ok ? t : 0);
            av[i] = *(const u32x4*)(Z + zoff(row, C_UB + lane * 8));
        }
#pragma unroll
        for (int i = 0; i < 12; ++i) {
            const int rr = w + 8 * i, t = t0 - 30 + rr;
            if (rr < 94) {
                u32x4 o = {0u, 0u, 0u, 0u};
                if (t >= 0) o = av[i];
                *(u32x4*)(vt + rr * 512 + lane * 8) = o;
            }
        }
    }
    __syncthreads();
    if (tile == 31) {
        for (int j = 0; j < 30; ++j) OUTP()[O_PCONV + ((size_t)(l * 8 + b) * 30 + j) * 512 + c] = bf2f(vt[(64 + j) * 512 + c]);
    }
#pragma unroll 1
    for (int sb = 0; sb < 4; ++sb) {
        float acc[16];
#pragma unroll
        for (int o = 0; o < 16; ++o) acc[o] = bias;
#pragma unroll
        for (int j = 0; j < 46; ++j) {
            const float v = bf2f(vt[(sb * 16 + j) * 512 + c]);
#pragma unroll
            for (int o = 0; o < 16; ++o) { const int k = j - o; if (k >= 0 && k < 31) acc[o] += wk[k] * v; }
        }
#pragma unroll
        for (int o = 0; o < 16; ++o) co[o * 512 + c] = acc[o];
        __syncthreads();
        { u32x4 z0 = zbv[0], z1 = zbv[1];
          if (sb == 1) { z0 = zbv[2]; z1 = zbv[3]; } else if (sb == 2) { z0 = zbv[4]; z1 = zbv[5]; } else if (sb == 3) { z0 = zbv[6]; z1 = zbv[7]; }
          conv_ln_rows(p, l, co, (size_t)b * SEQ + t0 + sb * 16 + w, lane, w, z0);
          conv_ln_rows(p, l, co, (size_t)b * SEQ + t0 + sb * 16 + 8 + w, lane, 8 + w, z1); }
        __syncthreads();
    }
}

__device__ __forceinline__ void conv_sample_task(const Params& p, int l, int bs) {
    const int c = opaque_tid(), w = c >> 6, lane = c & 63;
    float* co = (float*)smem;
    const bf16_t* Z = (const bf16_t*)(WS(p) + W_Z);
    const float* __restrict__ st = IN(I_SCONV) + (size_t)(l * 128 + bs) * 30 * 512 + c;
    float* __restrict__ nb = OUTP() + O_SCONV + (size_t)(l * 128 + bs) * 30 * 512 + c;
    const float* __restrict__ cw = IN(I_CONVW) + (size_t)l * 31 * 512 + c;
    float f[30];
#pragma unroll
    for (int k = 0; k < 30; ++k) f[k] = st[(size_t)k * 512];
    const size_t row = (size_t)TP + bs;
    const float v = bf2f(Z[zoff(row, C_UB + c)]);
    float acc = IN(I_CONVB)[l * 512 + c];
#pragma unroll
    for (int k = 0; k < 30; ++k) acc += cw[(size_t)k * 512] * f[k];
    acc += cw[(size_t)30 * 512] * v;
#pragma unroll
    for (int k = 1; k < 30; ++k) nb[(size_t)(k - 1) * 512] = f[k];
    nb[(size_t)29 * 512] = v;
    co[c] = acc;
    __syncthreads();
    if (w == 0) conv_ln_rows(p, l, co, row, lane, 0, *(const u32x4*)(Z + zoff(row, C_ZB + lane * 8)));
    __syncthreads();
}

constexpr int KS_STRIDE = 272, VS_STRIDE = 528, KS_BYTES = 256 * KS_STRIDE;
__device__ __forceinline__ void attn_prompt_task(const Params& p, int l, int item) {
    const int tid = opaque_tid(), w = tid >> 6, lane = tid & 63, fr = lane & 15, fq = lane >> 4;
    const int hp = item & 1, tile = (item >> 1) & 15, b = item >> 5;
    const bf16_t* Z = (const bf16_t*)(WS(p) + W_Z);
    const bf16_t* Kb = (const bf16_t*)(WS(p) + W_KB) + ((size_t)l * 2048 + b * 256) * 512;
    const bf16_t* Vt = (const bf16_t*)(WS(p) + W_VT) + ((size_t)l * 2048 * 512) + (size_t)b * 4 * 128 * 256;
    bf16_t* Ob = (bf16_t*)(WS(p) + W_ABR) + 512;
    LAS unsigned char* Ks = (LAS unsigned char*)smem;
    LAS unsigned char* Vs = (LAS unsigned char*)smem + KS_BYTES;
    const size_t row = (size_t)b * SEQ + tile * 128 + w * 16 + fr;
    const float sc = 1.4426950408889634f * 0.08838834764831845f;
#pragma unroll 1
    for (int hh = 0; hh < 2; ++hh) {
        const int head = hp * 2 + hh;
        __syncthreads();
        bf16x8 qf[4];
        u32x2 zxv[8];
        {
            const int c = tid & 15, r0 = tid >> 4;
            const int c2 = tid & 31, q0 = tid >> 5;
            u32x4 kt[8], vtl[8];
#pragma unroll
            for (int i = 0; i < 8; ++i) kt[i] = *(const u32x4*)(Kb + (size_t)(r0 + 32 * i) * 512 + head * 128 + c * 8);
#pragma unroll
            for (int i = 0; i < 8; ++i) vtl[i] = *(const u32x4*)(Vt + ((size_t)(head * 128 + q0 + 16 * i)) * 256 + c2 * 8);
#pragma unroll
            for (int ks = 0; ks < 4; ++ks) qf[ks] = *(const bf16x8*)(Z + zoff(row, C_Q + head * 128 + ks * 32 + 8 * fq));
#pragma unroll
            for (int e = 0; e < 8; ++e) zxv[e] = *(const u32x2*)(Z + zoff(row, C_ZX + head * 128 + 16 * e + 4 * fq));
#pragma unroll
            for (int i = 0; i < 8; ++i) *(LAS u32x4*)(Ks + (r0 + 32 * i) * KS_STRIDE + c * 16) = kt[i];
#pragma unroll
            for (int i = 0; i < 8; ++i) *(LAS u32x4*)(Vs + (q0 + 16 * i) * VS_STRIDE + c2 * 16) = vtl[i];
        }
        __syncthreads();
        f32x4 s[16];
#pragma unroll
        for (int mt = 0; mt < 16; ++mt) {
            f32x4 a = {0.f, 0.f, 0.f, 0.f};
#pragma unroll
            for (int ks = 0; ks < 4; ++ks) {
                const bf16x8 kf = *(const LAS bf16x8*)(Ks + (mt * 16 + fr) * KS_STRIDE + ks * 64 + fq * 16);
                a = __builtin_amdgcn_mfma_f32_16x16x32_bf16(kf, qf[ks], a, 0, 0, 0);
            }
            s[mt] = a;
        }
        float mx = -3.0e38f;
#pragma unroll
        for (int mt = 0; mt < 16; ++mt) mx = fmaxf(mx, fmaxf(fmaxf(s[mt][0], s[mt][1]), fmaxf(s[mt][2], s[mt][3])));
        mx = fmaxf(mx, __shfl_xor(mx, 16)); mx = fmaxf(mx, __shfl_xor(mx, 32));
        float sum = 0.f;
#pragma unroll
        for (int mt = 0; mt < 16; ++mt)
#pragma unroll
            for (int r = 0; r < 4; ++r) { const float e = __builtin_amdgcn_exp2f((s[mt][r] - mx) * sc); s[mt][r] = e; sum += e; }
        sum += __shfl_xor(sum, 16); sum += __shfl_xor(sum, 32);
        const float inv = 1.0f / sum;
        f32x4 o[8];
#pragma unroll
        for (int e = 0; e < 8; ++e) o[e] = (f32x4){0.f, 0.f, 0.f, 0.f};
#pragma unroll
        for (int ks = 0; ks < 8; ++ks) {
            union { bf16x8 v; unsigned u[4]; } pf;
            pf.u[0] = cvt_pk_bf16(s[2 * ks][0], s[2 * ks][1]); pf.u[1] = cvt_pk_bf16(s[2 * ks][2], s[2 * ks][3]);
            pf.u[2] = cvt_pk_bf16(s[2 * ks + 1][0], s[2 * ks + 1][1]); pf.u[3] = cvt_pk_bf16(s[2 * ks + 1][2], s[2 * ks + 1][3]);
#pragma unroll
            for (int e = 0; e < 8; ++e) {
                LAS unsigned char* vp = Vs + (16 * e + fr) * VS_STRIDE + (32 * ks + 4 * fq) * 2;
                union { bf16x8 v; u32x2 h[2]; } vf;
                vf.h[0] = *(const LAS u32x2*)vp; vf.h[1] = *(const LAS u32x2*)(vp + 32);
                o[e] = __builtin_amdgcn_mfma_f32_16x16x32_bf16(vf.v, pf.v, o[e], 0, 0, 0);
            }
        }
#pragma unroll
        for (int e = 0; e < 8; ++e) {
            const int col = head * 128 + 16 * e + 4 * fq;
            const u32x2 zx = zxv[e];
            f32x4 r;
            r[0] = o[e][0] * inv * bflo(zx.x); r[1] = o[e][1] * inv * bfhi(zx.x); r[2] = o[e][2] * inv * bflo(zx.y); r[3] = o[e][3] * inv * bfhi(zx.y);
            *(u32x2*)(Ob + row * 1536 + col) = pack4(r);
        }
    }
    __syncthreads();
}

__device__ __forceinline__ void attn_sample_task(const Params& p, int l, int item) {
    const int tid = opaque_tid(), w = tid >> 6, lane = tid & 63;
    const int bs = item >> 1, h0 = (item & 1) * 2;
    const bf16_t* Z = (const bf16_t*)(WS(p) + W_Z);
    bf16_t* Ob = (bf16_t*)(WS(p) + W_ABR) + 512;
    float* scs = (float*)smem;
    float* red = (float*)(smem + 2048);
    const size_t row = (size_t)TP + bs;
    const float* Kc = IN(I_CK) + ((size_t)(l * 128 + bs) * 256) * 512 + h0 * 128;
    const float* Vc = IN(I_CV) + ((size_t)(l * 128 + bs) * 256) * 512 + h0 * 128;
    const float sc = 1.4426950408889634f * 0.08838834764831845f;
    const bf16_t zxg = Z[zoff(row, C_ZX + h0 * 128 + (tid & 255))];
    {
        const int hh = lane >> 5, d4 = lane & 31;
        const u32x2 qq = *(const u32x2*)(Z + zoff(row, C_Q + (h0 + hh) * 128 + d4 * 4));
        const float q0 = bflo(qq.x), q1 = bfhi(qq.x), q2 = bflo(qq.y), q3 = bfhi(qq.y);
        f32x4 kv[32];
#pragma unroll
        for (int i = 0; i < 32; ++i) kv[i] = __builtin_nontemporal_load((const f32x4*)(Kc + (size_t)(w * 32 + i) * 512 + lane * 4));
#pragma unroll
        for (int i = 0; i < 32; ++i) {
            float d = kv[i][0] * q0 + kv[i][1] * q1 + kv[i][2] * q2 + kv[i][3] * q3;
            d += __shfl_xor(d, 16); d += __shfl_xor(d, 8); d += __shfl_xor(d, 4); d += __shfl_xor(d, 2); d += __shfl_xor(d, 1);
            if (d4 == 0) scs[hh * 256 + w * 32 + i] = d;
        }
    }
    __syncthreads();
    f32x4 vv[32];
#pragma unroll
    for (int i = 0; i < 32; ++i) vv[i] = __builtin_nontemporal_load((const f32x4*)(Vc + (size_t)(w * 32 + i) * 512 + lane * 4));
    if (w < 2) {
        float v[4]; float mx = -3.0e38f;
#pragma unroll
        for (int i = 0; i < 4; ++i) { v[i] = scs[w * 256 + lane + 64 * i]; mx = fmaxf(mx, v[i]); }
        mx = wave_max(mx);
        float sum = 0.f;
#pragma unroll
        for (int i = 0; i < 4; ++i) { v[i] = exp2f((v[i] - mx) * sc); sum += v[i]; }
        sum = wave_sum(sum);
        const float inv = 1.0f / sum;
#pragma unroll
        for (int i = 0; i < 4; ++i) scs[w * 256 + lane + 64 * i] = v[i] * inv;
    }
    __syncthreads();
    {
        const int hh = lane >> 5;
        f32x4 acc = {0.f, 0.f, 0.f, 0.f};
#pragma unroll
        for (int i = 0; i < 32; ++i) acc += vv[i] * scs[hh * 256 + w * 32 + i];
        *(f32x4*)(red + w * 256 + lane * 4) = acc;
    }
    __syncthreads();
    if (tid < 256) {
        float o = 0.f;
#pragma unroll
        for (int ww = 0; ww < 8; ++ww) o += red[ww * 256 + tid];
        const int col = h0 * 128 + tid;
        o *= bf2f(zxg);
        Ob[row * 1536 + col] = f2bf(o);
    }
    __syncthreads();
}

__device__ __forceinline__ void phase_mid(const Params& p, int l) {
    const int G = gridDim.x, bx = blockIdx.x;
    const bool early = ((bx >> 3) & 1) != 0;
    if (early) {
#pragma unroll 1
        for (int it = bx; it < 256; it += G) attn_sample_task(p, l, it);
    }
#pragma unroll 1
    for (int it = bx; it < 256; it += G) ssm_prompt_task(p, l, it >> 5, it & 31);
#pragma unroll 1
    for (int it = bx; it < 256; it += G) attn_prompt_task(p, l, it);
#pragma unroll 1
    for (int it = bx; it < 256; it += G) conv_prompt_task(p, l, it >> 5, it & 31);
#pragma unroll 1
    for (int it = bx; it < 256; it += G) ssm_sample_task(p, l, it);
#pragma unroll 1
    for (int it = bx; it < 128; it += G) conv_sample_task(p, l, it);
    if (!early) {
#pragma unroll 1
        for (int it = bx; it < 256; it += G) attn_sample_task(p, l, it);
    }
}

__global__ void __launch_bounds__(NTHREADS) fwd_megakernel(Params p) {
    cg::grid_group grid = cg::this_grid();
    if (WS(p) == nullptr) grid.sync();
    volatile LAS unsigned* st = (volatile LAS unsigned*)((LAS unsigned char*)smem + LDS_ST_OFF);
    if (threadIdx.x == 0) { st[0] = 0u; st[1] = 0u; st[2] = 0u; st[3] = 0u; }
    __syncthreads();
    const XcdBarrier gb = xcd_barrier_post((unsigned*)(WS(p) + W_BAR), st);
    phase_prep(p);
    xcd_barrier(gb);
    phase_inproj(p, 0);
    xcd_barrier(gb);
    phase_mid(p, 0);
    convert_weights(p, 1, 0, gridDim.x);
    xcd_barrier(gb);
    phase_glu_br(p, 0);
    xcd_barrier(gb);
    phase_out(p, 0);
    xcd_barrier(gb);
    phase_norm(p, 1);
    xcd_barrier(gb);
    phase_inproj(p, 1);
    xcd_barrier(gb);
    phase_mid(p, 1);
    xcd_barrier(gb);
    phase_glu_br(p, 1);
    xcd_barrier(gb);
    phase_out(p, 1);
    xcd_barrier(gb);
    phase_final(p);
}

extern "C" void kernel_launch(void* const* d_in, const int* in_sizes, int n_in, void* d_out, int out_size, void* d_ws, size_t ws_size, hipStream_t stream) {
    static int grid_blocks = 0;
    if (!grid_blocks) {
        int dev = 0, cus = 0, per_cu = 0;
        (void)hipGetDevice(&dev);
        (void)hipDeviceGetAttribute(&cus, hipDeviceAttributeMultiprocessorCount, dev);
        (void)hipFuncSetAttribute((const void*)fwd_megakernel, hipFuncAttributeMaxDynamicSharedMemorySize, LDS_BYTES);
        (void)hipOccupancyMaxActiveBlocksPerMultiprocessor(&per_cu, (const void*)fwd_megakernel, NTHREADS, LDS_BYTES);
        if (per_cu < 1) per_cu = 1;
        if (per_cu > 1) per_cu = 1;
        grid_blocks = cus * per_cu;
        if (ws_size < W_END) fprintf(stderr, "kernel_launch: workspace too small: %zu < %zu\n", ws_size, (size_t)W_END);
    }
    Params p{};
    for (int i = 0; i < 32; ++i) p.in[i] = (const float*)d_in[i];
    p.out = (float*)d_out; p.ws = (unsigned char*)d_ws;
    void* args[] = {&p};
    (void)hipMemsetAsync((unsigned char*)d_ws + W_BAR, 0, 16384, stream);
    hipError_t e = hipLaunchCooperativeKernel((const void*)fwd_megakernel, dim3(grid_blocks), dim3(NTHREADS), args, LDS_BYTES, stream);
    if (e != hipSuccess) fprintf(stderr, "cooperative launch failed: %s (grid %d)\n", hipGetErrorString(e), grid_blocks);
}
```
